# Optimizing an MI355X kernel written in HIP

```python
import math
import jax
import jax.numpy as jnp
from jax import lax
import numpy as np


D_MODEL = 1024
BATCH = 16
SEQ = 2048
DEPTH = 2

GRID_W = 64
CTX_LEN = 256
EPS = 1e-6
LOG_FLOOR = 1e-30
N_BRANCH = 4
BRANCH_W = D_MODEL // 4
HEAD_DIM = 64
CHUNK = 64
DN_HEADS = BRANCH_W // HEAD_DIM
DN_CONV = 5
S5_WIDTH = BRANCH_W
S5_GROUP = 16
S5_GROUPS = S5_WIDTH // S5_GROUP
S5_STATE = 64
HG_HEADS = BRANCH_W // HEAD_DIM
ATT_HEADS = BRANCH_W // HEAD_DIM
ATT_KV_HEADS = ATT_HEADS // 2
ATT_GROUP = ATT_HEADS // ATT_KV_HEADS
ATT_BLOCK = 128
ROPE_THETA = 10000.0
D_FF = ((8 * D_MODEL // 3 + 127) // 128) * 128
MACARON_W = 0.5
N_MOD = 9
IN_SIZES = (
    3 * BRANCH_W,
    BRANCH_W,
    2 * DN_HEADS,
    2 * DN_HEADS,
    S5_WIDTH,
    BRANCH_W,
    2 * BRANCH_W,
    BRANCH_W,
    BRANCH_W,
    ATT_HEADS * HEAD_DIM,
    2 * ATT_KV_HEADS * HEAD_DIM,
    N_BRANCH * D_MODEL,
)
IN_COLS = sum(IN_SIZES)

kernel_name = 'hybrid_parallel_flow_block'


def rms_norm(x, g):
    xf = x.astype(jnp.float32)
    y = xf * lax.rsqrt(jnp.mean(xf * xf, axis=-1, keepdims=True) + EPS)
    return (y * g.astype(jnp.float32)).astype(x.dtype)


def modulate(h, shift, scale):
    return h * (1.0 + scale) + shift


def ada_mods(cond, w, b):
    m = jax.nn.silu(cond) @ w + b
    m = m.reshape(m.shape[:-1] + (N_MOD, D_MODEL))
    return [m[..., i, :][..., None, :] for i in range(N_MOD)]


def split_cols(p):
    return jnp.split(p, np.cumsum(IN_SIZES)[:-1].tolist(), axis=-1)


def seq_join(part_c, part_l, reverse):
    if reverse:
        part_c, part_l = jnp.flip(part_c, axis=1), jnp.flip(part_l, axis=1)
    return jnp.concatenate([part_c, part_l], axis=1)


def seq_split(y, n_ctx, reverse):
    y_c, y_l = y[:, :n_ctx], y[:, n_ctx:]
    if reverse:
        y_c, y_l = jnp.flip(y_c, axis=1), jnp.flip(y_l, axis=1)
    return y_c, y_l


def dwconv_centred(x, w):
    k = w.shape[0]
    return lax.conv_general_dilated(x, w[:, None, :].astype(x.dtype), window_strides=(1,), padding=[(k // 2, k // 2)], dimension_numbers=('NWC', 'WIO', 'NWC'), feature_group_count=x.shape[-1])


def l2norm(t):
    return t * lax.rsqrt(jnp.sum(t * t, axis=-1, keepdims=True) + EPS)


def to_chunks(a, n):
    return a.reshape((a.shape[0], n, CHUNK) + a.shape[2:])


def axial_rope_tables(n_tokens):
    rows = n_tokens // GRID_W
    r, col = jnp.meshgrid(jnp.arange(rows), jnp.arange(GRID_W), indexing='ij')
    axis_dim = HEAD_DIM // 2
    inv = ROPE_THETA ** (-jnp.arange(0, axis_dim, 2, dtype=jnp.float32) / axis_dim)
    ang_r = r.reshape(-1, 1).astype(jnp.float32) * inv
    ang_c = col.reshape(-1, 1).astype(jnp.float32) * inv
    ang = jnp.concatenate([ang_r, ang_r, ang_c, ang_c], axis=-1)
    return jnp.cos(ang), jnp.sin(ang)


def apply_axial_rope(x, cos, sin):
    x1, x2, x3, x4 = jnp.split(x, 4, axis=-1)
    rot = jnp.concatenate([-x2, x1, -x4, x3], axis=-1)
    shape = (cos.shape[0],) + (1,) * (x.ndim - 3) + (HEAD_DIM,)
    return x * cos.reshape(shape) + rot * sin.reshape(shape)


def gated_delta_scan(q, k, v, g, beta):
    bsz, t_len, n_heads, dk = q.shape
    dv = v.shape[-1]
    n = t_len // CHUNK
    qc, kc, vc = (jnp.swapaxes(to_chunks(a, n), 2, 3) for a in (q, k, v))
    gc, bc = (jnp.swapaxes(to_chunks(a, n), 2, 3) for a in (g, beta))
    gcum = jnp.cumsum(gc, axis=-1)
    pos = jnp.arange(CHUNK)
    incl = pos[:, None] >= pos[None, :]
    strict = pos[:, None] > pos[None, :]
    decay = jnp.where(incl, jnp.exp(jnp.where(incl, gcum[..., :, None] - gcum[..., None, :], 0.0)), 0.0)
    lower = jnp.where(strict, jnp.einsum('bnhid,bnhjd->bnhij', kc, kc) * decay * bc[..., :, None], 0.0)
    eye = jnp.eye(CHUNK, dtype=q.dtype)
    rhs = jnp.concatenate([vc * bc[..., None], kc * (bc * jnp.exp(gcum))[..., None]], axis=-1)
    sol = lax.linalg.triangular_solve(eye + lower, rhs, left_side=True, lower=True)
    u, w = sol[..., :dv], sol[..., dv:]
    attn = jnp.einsum('bnhid,bnhjd->bnhij', qc, kc) * decay
    q_dec = qc * jnp.exp(gcum)[..., None]
    k_dec = kc * jnp.exp(gcum[..., -1:] - gcum)[..., None]
    g_last = jnp.exp(gcum[..., -1])

    def step(state, xs):
        u_i, w_i, attn_i, qd_i, kd_i, gl_i = xs
        v_new = u_i - jnp.einsum('bhck,bhkv->bhcv', w_i, state)
        o_i = jnp.einsum('bhck,bhkv->bhcv', qd_i, state) + jnp.einsum('bhij,bhjv->bhiv', attn_i, v_new)
        state = state * gl_i[..., None, None] + jnp.einsum('bhck,bhcv->bhkv', kd_i, v_new)
        return state, o_i

    xs = tuple(jnp.moveaxis(a, 1, 0) for a in (u, w, attn, q_dec, k_dec, g_last))
    _, o = lax.scan(step, jnp.zeros((bsz, n_heads, dk, dv), q.dtype), xs)
    return jnp.swapaxes(jnp.moveaxis(o, 0, 1), 2, 3).reshape(bsz, t_len, n_heads, dv)


def hgrn2_scan(q, log_f, k, v):
    bsz, t_len, n_heads, dk = q.shape
    dv = v.shape[-1]
    n = t_len // CHUNK
    bcum = jnp.cumsum(to_chunks(log_f, n), axis=2)
    pos = jnp.arange(CHUNK)
    incl = (pos[:, None] >= pos[None, :])[None, :, :, None, None]

    def step(state, xs):
        q_i, k_i, v_i, b_i = xs
        diff = jnp.where(incl, b_i[:, :, None] - b_i[:, None, :], 0.0)
        w_ts = jnp.where(incl, jnp.exp(diff), 0.0)
        scores = jnp.einsum('bthk,bshk,btshk->bhts', q_i, k_i, w_ts)
        b_last = b_i[:, -1]
        o_i = jnp.einsum('bhts,bshv->bthv', scores, v_i) + jnp.einsum('bthk,bhkv->bthv', q_i * jnp.exp(b_i), state)
        state = state * jnp.exp(b_last)[..., None] + jnp.einsum('bshk,bshv->bhkv', k_i * jnp.exp(b_last[:, None] - b_i), v_i)
        return state, o_i

    xs = tuple(jnp.moveaxis(a, 1, 0) for a in (to_chunks(q, n), to_chunks(k, n), to_chunks(v, n), bcum))
    _, o = lax.scan(step, jnp.zeros((bsz, n_heads, dk, dv), q.dtype), xs)
    return jnp.moveaxis(o, 0, 1).reshape(bsz, t_len, n_heads, dv)


def complex_affine_combine(e1, e2):
    a1r, a1i, b1r, b1i = e1
    a2r, a2i, b2r, b2i = e2
    return (a2r * a1r - a2i * a1i, a2r * a1i + a2i * a1r, a2r * b1r - a2i * b1i + b2r, a2r * b1i + a2i * b1r + b2i)


def s5_scan(u, lam_re, lam_im, log_step, b_re, b_im):
    lam_re, lam_im = lam_re.astype(jnp.float32), lam_im.astype(jnp.float32)
    step = jnp.exp(log_step.astype(jnp.float32))[:, None]
    mag = jnp.exp(lam_re * step)
    a_re, a_im = mag * jnp.cos(lam_im * step), mag * jnp.sin(lam_im * step)
    den = lam_re * lam_re + lam_im * lam_im
    n_re = a_re - 1.0
    coef_re = (n_re * lam_re + a_im * lam_im) / den
    coef_im = (a_im * lam_re - n_re * lam_im) / den
    b_re, b_im = b_re.astype(jnp.float32), b_im.astype(jnp.float32)
    bb_re = coef_re[..., None] * b_re - coef_im[..., None] * b_im
    bb_im = coef_re[..., None] * b_im + coef_im[..., None] * b_re
    x_re = jnp.einsum('btgh,gph->btgp', u, bb_re)
    x_im = jnp.einsum('btgh,gph->btgp', u, bb_im)
    shape = (1, u.shape[1]) + a_re.shape
    _, _, h_re, h_im = lax.associative_scan(complex_affine_combine, (jnp.broadcast_to(a_re, shape), jnp.broadcast_to(a_im, shape), x_re, x_im), axis=1)
    return h_re, h_im


def deltanet_mixer(qkv_c, qkv_l, z_c, z_l, a_c, a_l, b_c, b_l, conv_w, a_log, dt_bias, norm_g):
    dt = qkv_l.dtype
    n_ctx = qkv_c.shape[1]

    def prep(qkv):
        h = jax.nn.silu(dwconv_centred(qkv, conv_w)).astype(jnp.float32)
        h = h.reshape(h.shape[:2] + (3, DN_HEADS, HEAD_DIM))
        return l2norm(h[:, :, 0]) * HEAD_DIM ** -0.5, l2norm(h[:, :, 1]), h[:, :, 2]

    def gates(a, b, d):
        a = a.astype(jnp.float32)[..., d * DN_HEADS:(d + 1) * DN_HEADS]
        b = b.astype(jnp.float32)[..., d * DN_HEADS:(d + 1) * DN_HEADS]
        g = -jnp.exp(a_log[d].astype(jnp.float32)) * jax.nn.softplus(a + dt_bias[d].astype(jnp.float32))
        return g, jax.nn.sigmoid(b)

    qc, kc, vc = prep(qkv_c)
    ql, kl, vl = prep(qkv_l)
    oc, ol = [], []
    for d in range(2):
        rev = d == 1
        g_c, beta_c = gates(a_c, b_c, d)
        g_l, beta_l = gates(a_l, b_l, d)
        o = gated_delta_scan(seq_join(qc, ql, rev), seq_join(kc, kl, rev), seq_join(vc, vl, rev), seq_join(g_c, g_l, rev), seq_join(beta_c, beta_l, rev))
        o_c, o_l = seq_split(o, n_ctx, rev)
        oc.append(o_c)
        ol.append(o_l)

    def out(o, z):
        y = rms_norm(o, norm_g) * jax.nn.silu(z.astype(jnp.float32).reshape(o.shape))
        return y.reshape(o.shape[:2] + (BRANCH_W,)).astype(dt)

    return out(oc[0] + oc[1], z_c), out(ol[0] + ol[1], z_l)


def s5_mixer(u_c, u_l, lam_re, lam_im, log_step, b_re, b_im, c_re, c_im, d_skip, w_glu):
    dt = u_l.dtype
    n_ctx = u_c.shape[1]

    def grp(u):
        return u.astype(jnp.float32).reshape(u.shape[:2] + (S5_GROUPS, S5_GROUP))

    gu_c, gu_l = grp(u_c), grp(u_l)
    c_re, c_im = c_re.astype(jnp.float32), c_im.astype(jnp.float32)
    yc, yl = [], []
    for d in range(2):
        rev = d == 1
        h_re, h_im = s5_scan(seq_join(gu_c, gu_l, rev), lam_re[d], lam_im[d], log_step[d], b_re, b_im)
        y = jnp.einsum('gkp,btgp->btgk', c_re, h_re) - jnp.einsum('gkp,btgp->btgk', c_im, h_im)
        y_c, y_l = seq_split(y, n_ctx, rev)
        yc.append(y_c)
        yl.append(y_l)

    def out(y, u):
        y = (y + d_skip.astype(jnp.float32).reshape(S5_GROUPS, S5_GROUP) * u).reshape(u.shape[:2] + (S5_WIDTH,))
        ab = jax.nn.gelu(y) @ w_glu.astype(jnp.float32)
        return (ab[..., :S5_WIDTH] * jax.nn.sigmoid(ab[..., S5_WIDTH:])).astype(dt)

    return out(yc[0] + yc[1], gu_c), out(yl[0] + yl[1], gu_l)


def hgrn2_mixer(q_c, q_l, f_c, f_l, v_c, v_l, g_c, g_l, lb, norm_g):
    dt = q_l.dtype
    n_ctx = q_c.shape[1]
    lb = lb.astype(jnp.float32).reshape(HG_HEADS, HEAD_DIM)

    def heads(t):
        return t.astype(jnp.float32).reshape(t.shape[:2] + (HG_HEADS, HEAD_DIM))

    def forget(f, d):
        f = heads(f[..., d * BRANCH_W:(d + 1) * BRANCH_W])
        f_gate = lb + (1.0 - lb) * jax.nn.sigmoid(f)
        return jnp.log(jnp.maximum(f_gate, LOG_FLOOR)), (1.0 - lb) * jax.nn.sigmoid(-f)

    qc, ql = jax.nn.silu(heads(q_c)), jax.nn.silu(heads(q_l))
    vc, vl = heads(v_c), heads(v_l)
    oc, ol = [], []
    for d in range(2):
        rev = d == 1
        lf_c, k_c = forget(f_c, d)
        lf_l, k_l = forget(f_l, d)
        o = hgrn2_scan(seq_join(qc, ql, rev), seq_join(lf_c, lf_l, rev), seq_join(k_c, k_l, rev), seq_join(vc, vl, rev))
        o_c, o_l = seq_split(o, n_ctx, rev)
        oc.append(o_c)
        ol.append(o_l)

    def out(o, g):
        y = rms_norm(o, norm_g) * jax.nn.sigmoid(heads(g))
        return y.reshape(o.shape[:2] + (BRANCH_W,)).astype(dt)

    return out(oc[0] + oc[1], g_c), out(ol[0] + ol[1], g_l)


def attention_mixer(q_c, q_l, kv_c, kv_l, qn_g, kn_g, cos, sin):
    dt = q_l.dtype
    scale = HEAD_DIM ** -0.5

    def split_qkv(q, kv):
        bsz, t = q.shape[:2]
        q = rms_norm(q.astype(jnp.float32).reshape(bsz, t, ATT_KV_HEADS, ATT_GROUP, HEAD_DIM), qn_g)
        kv = kv.astype(jnp.float32).reshape(bsz, t, 2, ATT_KV_HEADS, HEAD_DIM)
        return q, rms_norm(kv[:, :, 0], kn_g), kv[:, :, 1]

    qc, kc, vc = split_qkv(q_c, kv_c)
    ql, kl, vl = split_qkv(q_l, kv_l)
    ql, kl = apply_axial_rope(ql, cos, sin), apply_axial_rope(kl, cos, sin)
    p_c = jax.nn.softmax(jnp.einsum('bqkgd,bskd->bkgqs', qc, kc) * scale, axis=-1)
    oc = jnp.einsum('bkgqs,bskd->bqkgd', p_c, vc)
    keys = jnp.concatenate([kc, kl], axis=1)
    vals = jnp.concatenate([vc, vl], axis=1)
    bsz, n_lat = ql.shape[:2]
    qb = jnp.moveaxis(ql.reshape((bsz, n_lat // ATT_BLOCK, ATT_BLOCK) + ql.shape[2:]), 1, 0)

    def attend(q_blk):
        p = jax.nn.softmax(jnp.einsum('bqkgd,bskd->bkgqs', q_blk, keys) * scale, axis=-1)
        return jnp.einsum('bkgqs,bskd->bqkgd', p, vals)

    ol = jnp.moveaxis(lax.map(attend, qb), 0, 1)
    return oc.reshape(oc.shape[:2] + (BRANCH_W,)).astype(dt), ol.reshape(bsz, n_lat, BRANCH_W).astype(dt)


def merge_branches(ys, gates, w_branch, w_out):
    acc = None
    for i, y in enumerate(ys):
        term = jax.nn.sigmoid(gates[..., i * D_MODEL:(i + 1) * D_MODEL]) * (y @ w_branch[i])
        acc = term if acc is None else acc + term
    return acc @ w_out


def swiglu_half_step(x, g, shift, scale, gate, w1, w3, w2):
    h = modulate(rms_norm(x, g), shift, scale)
    return x + MACARON_W * gate * ((jax.nn.silu(h @ w1) * (h @ w3)) @ w2)


def setup_inputs(seed: int = 0) -> dict:
    key = jax.random.key(seed)
    ks = jax.random.split(key, 32)

    def nrm(i, shape, s):
        return s * jax.random.normal(ks[i], shape, jnp.float32)

    def unif(i, shape, lo, hi):
        return jax.random.uniform(ks[i], shape, jnp.float32, lo, hi)

    L = DEPTH
    dt0 = jnp.exp(unif(13, (L, 2, DN_HEADS), math.log(1e-3), math.log(1e-1)))
    return {
        'x': nrm(0, (BATCH, SEQ, D_MODEL), 1.0),
        'c': nrm(1, (BATCH, D_MODEL), 1.0),
        'ctx': nrm(2, (BATCH, CTX_LEN, D_MODEL), 1.0),
        'c_ctx': nrm(3, (D_MODEL,), 1.0),
        'ada_w': nrm(4, (L, D_MODEL, N_MOD * D_MODEL), 0.5 * D_MODEL ** -0.5),
        'ada_b': nrm(5, (L, N_MOD * D_MODEL), 0.02),
        'norm_g': 1.0 + nrm(6, (L, 3, D_MODEL), 0.05),
        'ffn_w1': nrm(7, (L, 2, D_MODEL, D_FF), D_MODEL ** -0.5),
        'ffn_w3': nrm(8, (L, 2, D_MODEL, D_FF), D_MODEL ** -0.5),
        'ffn_w2': nrm(9, (L, 2, D_FF, D_MODEL), D_FF ** -0.5),
        'w_in': nrm(10, (L, D_MODEL, IN_COLS), D_MODEL ** -0.5),
        'dn_conv': nrm(11, (L, DN_CONV, 3 * BRANCH_W), DN_CONV ** -0.5),
        'dn_a_log': jnp.log(unif(12, (L, 2, DN_HEADS), 1.0, 16.0)),
        'dn_dt_bias': dt0 + jnp.log(-jnp.expm1(-dt0)),
        'dn_norm_g': 1.0 + nrm(14, (L, HEAD_DIM), 0.05),
        's5_lam_re': -0.5 + nrm(15, (L, 2, S5_GROUPS, S5_STATE), 0.01),
        's5_lam_im': jnp.pi * jnp.arange(S5_STATE, dtype=jnp.float32) + nrm(16, (L, 2, S5_GROUPS, S5_STATE), 0.01),
        's5_log_step': unif(17, (L, 2, S5_GROUPS), math.log(1e-3), math.log(1e-1)),
        's5_b_re': nrm(18, (L, S5_GROUPS, S5_STATE, S5_GROUP), (2 * S5_GROUP) ** -0.5),
        's5_b_im': nrm(19, (L, S5_GROUPS, S5_STATE, S5_GROUP), (2 * S5_GROUP) ** -0.5),
        's5_c_re': nrm(20, (L, S5_GROUPS, S5_GROUP, S5_STATE), S5_STATE ** -0.5),
        's5_c_im': nrm(21, (L, S5_GROUPS, S5_GROUP, S5_STATE), S5_STATE ** -0.5),
        's5_d': nrm(22, (L, S5_WIDTH), 1.0),
        's5_glu': nrm(23, (L, S5_WIDTH, 2 * S5_WIDTH), S5_WIDTH ** -0.5),
        'hg_lb_logits': nrm(24, (L, HG_HEADS * HEAD_DIM), 0.1),
        'hg_norm_g': 1.0 + nrm(25, (L, HEAD_DIM), 0.05),
        'at_qn_g': 1.0 + nrm(26, (L, HEAD_DIM), 0.05),
        'at_kn_g': 1.0 + nrm(27, (L, HEAD_DIM), 0.05),
        'w_branch': nrm(28, (L, N_BRANCH, BRANCH_W, D_MODEL), BRANCH_W ** -0.5),
        'w_out': nrm(29, (L, D_MODEL, D_MODEL), D_MODEL ** -0.5),
        'final_g': 1.0 + nrm(30, (D_MODEL,), 0.05),
    }


def reference(x, c, ctx, c_ctx, ada_w, ada_b, norm_g, ffn_w1, ffn_w3, ffn_w2, w_in, dn_conv, dn_a_log, dn_dt_bias, dn_norm_g, s5_lam_re, s5_lam_im, s5_log_step, s5_b_re, s5_b_im, s5_c_re, s5_c_im, s5_d, s5_glu, hg_lb_logits, hg_norm_g, at_qn_g, at_kn_g, w_branch, w_out, final_g):
    cos, sin = axial_rope_tables(x.shape[1])
    lb_w = jax.nn.softmax(hg_lb_logits.astype(jnp.float32), axis=0)
    lower_bounds = jnp.cumsum(lb_w, axis=0) - lb_w[0:1]
    x_l, x_c = x, ctx
    for l in range(DEPTH):
        m_l = ada_mods(c, ada_w[l], ada_b[l])
        m_c = ada_mods(c_ctx, ada_w[l], ada_b[l])
        x_l = swiglu_half_step(x_l, norm_g[l, 0], m_l[0], m_l[1], m_l[2], ffn_w1[l, 0], ffn_w3[l, 0], ffn_w2[l, 0])
        x_c = swiglu_half_step(x_c, norm_g[l, 0], m_c[0], m_c[1], m_c[2], ffn_w1[l, 0], ffn_w3[l, 0], ffn_w2[l, 0])
        p_l = split_cols(modulate(rms_norm(x_l, norm_g[l, 1]), m_l[3], m_l[4]) @ w_in[l])
        p_c = split_cols(modulate(rms_norm(x_c, norm_g[l, 1]), m_c[3], m_c[4]) @ w_in[l])
        y_dn = deltanet_mixer(p_c[0], p_l[0], p_c[1], p_l[1], p_c[2], p_l[2], p_c[3], p_l[3], dn_conv[l], dn_a_log[l], dn_dt_bias[l], dn_norm_g[l])
        y_s5 = s5_mixer(p_c[4], p_l[4], s5_lam_re[l], s5_lam_im[l], s5_log_step[l], s5_b_re[l], s5_b_im[l], s5_c_re[l], s5_c_im[l], s5_d[l], s5_glu[l])
        y_hg = hgrn2_mixer(p_c[5], p_l[5], p_c[6], p_l[6], p_c[7], p_l[7], p_c[8], p_l[8], lower_bounds[l], hg_norm_g[l])
        y_at = attention_mixer(p_c[9], p_l[9], p_c[10], p_l[10], at_qn_g[l], at_kn_g[l], cos, sin)
        x_l = x_l + m_l[5] * merge_branches([y_dn[1], y_s5[1], y_hg[1], y_at[1]], p_l[11], w_branch[l], w_out[l])
        x_l = swiglu_half_step(x_l, norm_g[l, 2], m_l[6], m_l[7], m_l[8], ffn_w1[l, 1], ffn_w3[l, 1], ffn_w2[l, 1])
        if l < DEPTH - 1:
            x_c = x_c + m_c[5] * merge_branches([y_dn[0], y_s5[0], y_hg[0], y_at[0]], p_c[11], w_branch[l], w_out[l])
            x_c = swiglu_half_step(x_c, norm_g[l, 2], m_c[6], m_c[7], m_c[8], ffn_w1[l, 1], ffn_w3[l, 1], ffn_w2[l, 1])
    return rms_norm(x_l, final_g)
```

```cpp
#include <hip/hip_runtime.h>
#include <hip/hip_cooperative_groups.h>
#include <cstdio>
#include <cstring>
namespace cg = cooperative_groups;
#ifndef PROBE_MASK
#define PROBE_MASK 0
#endif

typedef unsigned short bf16_t;
using bf16x8 = __attribute__((ext_vector_type(8))) short;
using f32x4  = __attribute__((ext_vector_type(4))) float;
using u32x4  = __attribute__((ext_vector_type(4))) unsigned;
using u32x2  = __attribute__((ext_vector_type(2))) unsigned;

constexpr int DM = 1024, NBATCH = 16, SEQL = 2048, CTXL = 256, DFF = 2816;
constexpr int NLAT = NBATCH * SEQL;
constexpr int NCTXR = NBATCH * CTXL;
constexpr int NTOK = NLAT + NCTXR;
constexpr int PC = 3088;
constexpr int TJ = 2304;
constexpr int C_DNQKV = 0, C_DNZ = 768, C_DNA = 1024, C_DNB = 1032, C_S5U = 1040, C_HGQ = 1296, C_HGF = 1552,
              C_HGV = 2064, C_HGG = 2320, C_ATQ = 2576, C_ATK = 2832, C_ATV = 2960;
constexpr int C_YDN = 0, C_S5G = 256, C_YS5 = 512, C_YHG = 1296, C_YAT = 2832;

constexpr size_t W_UP = 0;
constexpr size_t W_DN = W_UP + 2ull * 5632 * 1024;
constexpr size_t W_IN = W_DN + 2ull * 1024 * 2816;
constexpr size_t W_GT = W_IN + 3200ull * 1024;
constexpr size_t W_BT = W_GT + 4096ull * 1024;
constexpr size_t W_OT = W_BT + 4ull * 1024 * 256;
constexpr size_t W_GLU = W_OT + 1024ull * 1024;
constexpr size_t W_ELEMS = W_GLU + 512ull * 256;
constexpr size_t OFF_W = 0;
constexpr size_t OFF_XC = OFF_W + W_ELEMS * 2;
constexpr size_t OFF_H = OFF_XC + (size_t)NCTXR * DM * 4;
constexpr size_t OFF_P = OFF_H + (size_t)NTOK * DM * 2;
constexpr size_t OFF_SC = OFF_P + (size_t)NTOK * PC * 2;
constexpr size_t OFF_KP = OFF_SC + 6ull * NTOK * 256 * 2;
constexpr size_t OFF_VT = OFF_KP + 16ull * 2 * TJ * 64 * 2;
constexpr size_t OFF_MOD = OFF_VT + 16ull * 2 * TJ * 64 * 2;
constexpr size_t OFF_CTR = OFF_MOD + 2ull * 17 * 9 * 1024 * 4;
constexpr size_t CTL_BYTES = 16384;
constexpr size_t WS_END = OFF_CTR + CTL_BYTES;
static_assert(WS_END <= 512ull * 1024 * 1024, "workspace too large");
static_assert((OFF_XC % 256) == 0 && (OFF_H % 256) == 0 && (OFF_P % 256) == 0 && (OFF_SC % 256) == 0 && (OFF_KP % 256) == 0 && (OFF_MOD % 256) == 0, "align");

struct CvtJob { const float* src; bf16_t* dst; int K, N, nsrc, ld_src, ld_dst, mode, ntk, tile0; };
struct Params {
  const float* in[31];
  float* out;
  char* ws;
  CvtJob jobs[30];
  int job_tiles[2];
  int pad[2];
};

__device__ __forceinline__ float bf2f(bf16_t b) { return __uint_as_float(((unsigned)b) << 16); }
__device__ __forceinline__ float bflo(unsigned u) { return __uint_as_float(u << 16); }
__device__ __forceinline__ float bfhi(unsigned u) { return __uint_as_float(u & 0xffff0000u); }
typedef __bf16 hwbf2_t __attribute__((ext_vector_type(2)));
typedef float hwf2_t __attribute__((ext_vector_type(2)));
__device__ __forceinline__ unsigned pack2(float a, float b) {
  hwf2_t v; v.x = a; v.y = b;
  const hwbf2_t r = __builtin_convertvector(v, hwbf2_t);
  return __builtin_bit_cast(unsigned, r);
}
__device__ __forceinline__ bf16_t f2bf(float f) { return (bf16_t)(pack2(f, 0.f) & 0xffffu); }
__device__ __forceinline__ float sigm(float x) { return __builtin_amdgcn_rcpf(1.f + __expf(-x)); }
__device__ __forceinline__ float silu(float x) { return x * sigm(x); }
__device__ __forceinline__ float wave_sum(float v) {
#pragma unroll
  for (int o = 32; o >= 1; o >>= 1) v += __shfl_xor(v, o);
  return v;
}
__device__ __forceinline__ float quad_sum(float x) {
  x += __int_as_float(__builtin_amdgcn_update_dpp(0, __float_as_int(x), 0xB1, 0xF, 0xF, true));
  x += __int_as_float(__builtin_amdgcn_update_dpp(0, __float_as_int(x), 0x4E, 0xF, 0xF, true));
  return x;
}
__device__ __forceinline__ int otid() { int t = threadIdx.x; asm volatile("" : "+v"(t)); return t; }
__device__ __forceinline__ int frag_off(int fr, int fq) { return (fr >> 3) * 1024 + (fr & 7) * 128 + ((fq ^ ((fr >> 1) & 7)) << 4); }
__device__ __forceinline__ int lds_inner(int fr, int cbyte) { int ob = fr * 64 + cbyte; return ob ^ (((ob >> 9) & 1) << 5); }
__device__ __forceinline__ int lds_byte(int r, int c) { return ((r >> 4) * 2 + (c >> 5)) * 1024 + lds_inner(r & 15, (c & 31) * 2); }
__device__ __forceinline__ int seq_row(int b, int dir, int s) {
  if (s < CTXL) { int pos = dir ? (CTXL - 1 - s) : s; return NLAT + b * CTXL + pos; }
  int sl = s - CTXL; int pos = dir ? (SEQL - 1 - sl) : sl; return b * SEQL + pos;
}
__device__ __forceinline__ int mod_idx(int row) { return row < NLAT ? (row >> 11) : 16; }

template <int NT, bool LEAN = false>
__device__ __forceinline__ void gemm_main(const bf16_t* __restrict__ A, int lda, const bf16_t* __restrict__ Bt, int ldb, int K,
                                          f32x4 (&acc)[4][NT], char* smem, int bs1 = 32, int bs2 = 64) {
  const int tid = otid(), lane = tid & 63, wid = tid >> 6, wr = wid >> 1, wc = wid & 1, fr = lane & 15, fq = lane >> 4;
  const int o0 = tid * 16;
  const int lrow = (o0 >> 10) * 8 + ((o0 >> 7) & 7), lcol = ((((o0 >> 4) & 7) ^ ((lrow >> 1) & 7))) * 8;
  const bf16_t* ag = A + (size_t)lrow * lda + lcol;
  const bf16_t* bg = Bt + (size_t)lrow * ldb + lcol;
  const char* A8 = (const char*)A;
  const char* B8 = (const char*)Bt;
  unsigned aoff[4], boff[NT];
#pragma unroll
  for (int i = 0; i < 4; ++i) aoff[i] = (unsigned)(((lrow + 32 * i) * lda + lcol) * 2);
#pragma unroll
  for (int i = 0; i < NT; ++i) boff[i] = (unsigned)(((lrow + (i & 1) * bs1 + (i >> 1) * bs2) * ldb + lcol) * 2);
  const int wbase = __builtin_amdgcn_readfirstlane(wid) * 1024;
  const int inner = frag_off(fr, fq);
  const int abase = wr * 8192 + inner;
  const int bbase = 16384 + wc * (NT * 2048) + inner;
  const int nk = K >> 6;
#pragma unroll
  for (int i = 0; i < 4; ++i) __builtin_amdgcn_global_load_lds((const unsigned*)(ag + (size_t)(32 * i) * lda), (unsigned*)(smem + i * 4096 + o0), 16, 0, 0);
#pragma unroll
  for (int i = 0; i < NT; ++i) __builtin_amdgcn_global_load_lds((const unsigned*)(bg + (size_t)((i & 1) * bs1 + (i >> 1) * bs2) * ldb), (unsigned*)(smem + 16384 + i * 4096 + o0), 16, 0, 0);
  asm volatile("s_waitcnt vmcnt(0)" ::: "memory");
  __syncthreads();
  for (int kt = 0; kt < nk; ++kt) {
    const int cur = (kt & 1) * 32768, nxt = 32768 - cur;
    if (kt + 1 < nk) {
#pragma unroll
      for (int i = 0; i < 4; ++i)
        __builtin_amdgcn_global_load_lds((const unsigned*)(A8 + (size_t)(kt + 1) * 128 + aoff[i]), (unsigned*)(smem + nxt + i * 4096 + wbase), 16, 0, 0);
#pragma unroll
      for (int i = 0; i < NT; ++i)
        __builtin_amdgcn_global_load_lds((const unsigned*)(B8 + (size_t)(kt + 1) * 128 + boff[i]), (unsigned*)(smem + nxt + 16384 + i * 4096 + wbase), 16, 0, 0);
    }
    __builtin_amdgcn_sched_barrier(0);
    if (LEAN) {
#pragma unroll
      for (int ks = 0; ks < 2; ++ks) {
        bf16x8 af[4], bfr[NT];
#pragma unroll
        for (int m = 0; m < 4; ++m) af[m] = *(const bf16x8*)(smem + cur + ((abase + m * 2048) ^ (ks * 64)));
#pragma unroll
        for (int n = 0; n < NT; ++n) bfr[n] = *(const bf16x8*)(smem + cur + ((bbase + n * 2048) ^ (ks * 64)));
        __builtin_amdgcn_s_setprio(1);
#pragma unroll
        for (int m = 0; m < 4; ++m)
#pragma unroll
          for (int n = 0; n < NT; ++n) acc[m][n] = __builtin_amdgcn_mfma_f32_16x16x32_bf16(bfr[n], af[m], acc[m][n], 0, 0, 0);
        __builtin_amdgcn_s_setprio(0);
      }
    } else {
    bf16x8 af0[4], bf0[NT], af1[4], bf1[NT];
#pragma unroll
    for (int m = 0; m < 4; ++m) af0[m] = *(const bf16x8*)(smem + cur + (abase + m * 2048));
#pragma unroll
    for (int n = 0; n < NT; ++n) bf0[n] = *(const bf16x8*)(smem + cur + (bbase + n * 2048));
#pragma unroll
    for (int m = 0; m < 4; ++m) af1[m] = *(const bf16x8*)(smem + cur + ((abase + m * 2048) ^ 64));
#pragma unroll
    for (int n = 0; n < NT; ++n) bf1[n] = *(const bf16x8*)(smem + cur + ((bbase + n * 2048) ^ 64));
    __builtin_amdgcn_sched_barrier(0);
    __builtin_amdgcn_s_setprio(1);
#pragma unroll
    for (int m = 0; m < 4; ++m)
#pragma unroll
      for (int n = 0; n < NT; ++n) acc[m][n] = __builtin_amdgcn_mfma_f32_16x16x32_bf16(bf0[n], af0[m], acc[m][n], 0, 0, 0);
#pragma unroll
    for (int m = 0; m < 4; ++m)
#pragma unroll
      for (int n = 0; n < NT; ++n) acc[m][n] = __builtin_amdgcn_mfma_f32_16x16x32_bf16(bf1[n], af1[m], acc[m][n], 0, 0, 0);
    __builtin_amdgcn_s_setprio(0);
    }
    __builtin_amdgcn_sched_barrier(0);
    asm volatile("s_waitcnt vmcnt(0)" ::: "memory");
    __syncthreads();
  }
}

template <int NT>
__device__ __forceinline__ void zero_acc(f32x4 (&acc)[4][NT]) {
#pragma unroll
  for (int m = 0; m < 4; ++m)
#pragma unroll
    for (int n = 0; n < NT; ++n) acc[m][n] = f32x4{0.f, 0.f, 0.f, 0.f};
}

#define WS_BF(p, off) ((bf16_t*)((p).ws + (off)))
#define WS_F32(p, off) ((float*)((p).ws + (off)))
__device__ __forceinline__ const float* mods_ptr(const Params& p, int l, int bi, int k) {
  return WS_F32(p, OFF_MOD) + ((size_t)((l * 17 + bi) * 9 + k)) * 1024;
}

__device__ __forceinline__ void cvt_tile(const CvtJob& j, int t, char* smem) {
  float* ts = (float*)smem;
  const int tid = otid();
  const int tk = t % j.ntk, tn = t / j.ntk, k0 = tk * 64, n0 = tn * 64;
  {
    const int n4 = (tid & 15) * 4, n = n0 + n4, kr = tid >> 4;
    float4 v[4];
#pragma unroll
    for (int i = 0; i < 4; ++i) {
      const int k = kr + 16 * i;
      v[i] = (n < j.nsrc) ? *(const float4*)(j.src + (size_t)(k0 + k) * j.ld_src + n) : float4{0.f, 0.f, 0.f, 0.f};
    }
#pragma unroll
    for (int i = 0; i < 4; ++i) {
      const int k = kr + 16 * i;
      ts[k * 65 + n4 + 0] = v[i].x; ts[k * 65 + n4 + 1] = v[i].y; ts[k * 65 + n4 + 2] = v[i].z; ts[k * 65 + n4 + 3] = v[i].w;
    }
  }
  __syncthreads();
#pragma unroll
  for (int i = 0; i < 2; ++i) {
    const int c = tid + 256 * i, nl = c >> 3, kc = (c & 7) * 8, n = n0 + nl;
    if (n < j.N) {
      const int row = (j.mode == 0) ? n : ((n >> 4) * 32 + (n & 15) + (j.mode == 2 ? 16 : 0));
      u32x4 o;
      o.x = pack2(ts[(kc + 0) * 65 + nl], ts[(kc + 1) * 65 + nl]);
      o.y = pack2(ts[(kc + 2) * 65 + nl], ts[(kc + 3) * 65 + nl]);
      o.z = pack2(ts[(kc + 4) * 65 + nl], ts[(kc + 5) * 65 + nl]);
      o.w = pack2(ts[(kc + 6) * 65 + nl], ts[(kc + 7) * 65 + nl]);
      *(u32x4*)(j.dst + (size_t)row * j.ld_dst + k0 + kc) = o;
    }
  }
  __syncthreads();
}
__device__ __forceinline__ void phase_cvt(const Params& p, int l, char* smem) {
  const int total = p.job_tiles[l];
  for (int t = blockIdx.x; t < total; t += gridDim.x) {
    int ji = 0;
#pragma unroll 1
    for (int q = 1; q < 15; ++q) if (t >= p.jobs[l * 15 + q].tile0) ji = q;
    const CvtJob& j = p.jobs[l * 15 + ji];
    cvt_tile(j, t - j.tile0, smem);
  }
}

__device__ __forceinline__ void phase_ada(const Params& p, char* smem) {
  float* sc = (float*)smem;
  const int tid = otid(), c = tid & 63, kg = tid >> 6;
  for (int task = blockIdx.x; task < 2 * 144; task += gridDim.x) {
    const int l = task / 144, n0 = (task % 144) * 64;
    const float* W = p.in[4] + (size_t)l * 1024 * 9216;
    float acc[17];
#pragma unroll
    for (int r = 0; r < 17; ++r) acc[r] = 0.f;
    for (int kh = 0; kh < 2; ++kh) {
      __syncthreads();
      for (int i = tid; i < 17 * 512; i += 256) {
        const int r = i >> 9, k = (i & 511) + kh * 512;
        const float v = (r < 16) ? p.in[1][r * 1024 + k] : p.in[3][k];
        sc[i] = silu(v);
      }
      __syncthreads();
#pragma unroll 4
      for (int kk = 0; kk < 128; kk += 4) {
        const int kl = kg * 128 + kk;
        const float* wp = W + (size_t)(kh * 512 + kl) * 9216 + n0 + c;
        const float w0 = wp[0], w1 = wp[9216], w2 = wp[2 * 9216], w3 = wp[3 * 9216];
#pragma unroll
        for (int r = 0; r < 17; ++r) {
          const float4 s4 = *(const float4*)(sc + r * 512 + kl);
          acc[r] += s4.x * w0 + s4.y * w1 + s4.z * w2 + s4.w * w3;
        }
      }
    }
    __syncthreads();
#pragma unroll
    for (int r = 0; r < 17; ++r) sc[(kg * 17 + r) * 64 + c] = acc[r];
    __syncthreads();
    for (int i = tid; i < 17 * 64; i += 256) {
      const int r = i >> 6, cc = i & 63;
      float s = 0.f;
#pragma unroll
      for (int g = 0; g < 4; ++g) s += sc[(g * 17 + r) * 64 + cc];
      const int n = n0 + cc;
      WS_F32(p, OFF_MOD)[(size_t)(l * 17 + r) * 9216 + n] = s + p.in[5][l * 9216 + n];
    }
    __syncthreads();
  }
}

__device__ __forceinline__ const float* xrow_ptr(const Params& p, bool from_input, int r) {
  if (from_input) return r < NLAT ? p.in[0] + (size_t)r * DM : p.in[2] + (size_t)(r - NLAT) * DM;
  return r < NLAT ? p.out + (size_t)r * DM : WS_F32(p, OFF_XC) + (size_t)(r - NLAT) * DM;
}
__device__ __forceinline__ float* xrow_out(const Params& p, int r) {
  return r < NLAT ? p.out + (size_t)r * DM : WS_F32(p, OFF_XC) + (size_t)(r - NLAT) * DM;
}
__device__ __forceinline__ void phase_norm(const Params& p, int l, int which, int nrows) {
  const float* g = p.in[6] + (l * 3 + which) * 1024;
  const int tidq = otid(); const int lane = tidq & 63;
  bf16_t* H = WS_BF(p, OFF_H);
  const bool from_input = (l == 0 && which == 0);
  const int nw = gridDim.x * 4, gw = blockIdx.x * 4 + (tidq >> 6);
  const int rpw = (nrows + nw - 1) / nw;
  const int r0 = gw * rpw, r1 = (r0 + rpw < nrows) ? r0 + rpw : nrows;
  float4 g4[4], s4[4], c4[4];
#pragma unroll
  for (int i = 0; i < 4; ++i) g4[i] = *(const float4*)(g + i * 256 + lane * 4);
  int cur_bi = -1;
  for (int r = r0; r < r1; ++r) {
    const float* xr = xrow_ptr(p, from_input, r);
    const int bi = mod_idx(r);
    if (bi != cur_bi) {
      const float* sh = mods_ptr(p, l, bi, which * 3);
#pragma unroll
      for (int i = 0; i < 4; ++i) { s4[i] = *(const float4*)(sh + i * 256 + lane * 4); c4[i] = *(const float4*)(sh + 1024 + i * 256 + lane * 4); }
      cur_bi = bi;
    }
    float4 v[4];
    float ss = 0.f;
#pragma unroll
    for (int i = 0; i < 4; ++i) {
      v[i] = *(const float4*)(xr + i * 256 + lane * 4);
      ss += v[i].x * v[i].x + v[i].y * v[i].y + v[i].z * v[i].z + v[i].w * v[i].w;
    }
    ss = wave_sum(ss);
    const float rstd = rsqrtf(ss * (1.f / 1024.f) + 1e-6f);
#pragma unroll
    for (int i = 0; i < 4; ++i) {
      const int c = i * 256 + lane * 4;
      const float y0 = (v[i].x * rstd * g4[i].x) * (1.f + c4[i].x) + s4[i].x;
      const float y1 = (v[i].y * rstd * g4[i].y) * (1.f + c4[i].y) + s4[i].y;
      const float y2 = (v[i].z * rstd * g4[i].z) * (1.f + c4[i].z) + s4[i].z;
      const float y3 = (v[i].w * rstd * g4[i].w) * (1.f + c4[i].w) + s4[i].w;
      u32x2 o; o.x = pack2(y0, y1); o.y = pack2(y2, y3);
      *(u32x2*)(H + (size_t)r * DM + c) = o;
    }
  }
}
__device__ __forceinline__ void phase_final_norm(const Params& p) {
  const float* g = p.in[30];
  const int tidq = otid(); const int lane = tidq & 63;
  float4 g4[4];
#pragma unroll
  for (int i = 0; i < 4; ++i) g4[i] = *(const float4*)(g + i * 256 + lane * 4);
  for (int r = blockIdx.x * 4 + (tidq >> 6); r < NLAT; r += gridDim.x * 4) {
    float* xr = p.out + (size_t)r * DM;
    float4 v[4];
    float ss = 0.f;
#pragma unroll
    for (int i = 0; i < 4; ++i) {
      v[i] = *(const float4*)(xr + i * 256 + lane * 4);
      ss += v[i].x * v[i].x + v[i].y * v[i].y + v[i].z * v[i].z + v[i].w * v[i].w;
    }
    ss = wave_sum(ss);
    const float rstd = rsqrtf(ss * (1.f / 1024.f) + 1e-6f);
#pragma unroll
    for (int i = 0; i < 4; ++i) {
      float4 o; o.x = v[i].x * rstd * g4[i].x; o.y = v[i].y * rstd * g4[i].y; o.z = v[i].z * rstd * g4[i].z; o.w = v[i].w * rstd * g4[i].w;
      *(float4*)(xr + i * 256 + lane * 4) = o;
    }
  }
}


struct TileIter {
  int e, ecount, nb, x, SH, SW, nsc;
  unsigned* cnt;
  unsigned tick;
  __device__ __forceinline__ TileIter(int ntm, int ntn, int sh, int sw, unsigned* cnt_ = nullptr) {
    x = blockIdx.x & 7; nb = gridDim.x >> 3; e = blockIdx.x >> 3; SH = sh; SW = sw; nsc = ntn / sw;
    const int NS = (ntm / sh) * nsc;
    ecount = ((NS - x + 7) >> 3) * sh * sw;
    cnt = cnt_ ? cnt_ + x : nullptr;
    tick = 0;
  }
  __device__ __forceinline__ bool valid() const { return e < ecount; }
  __device__ __forceinline__ void prefetch() {
    if (cnt && threadIdx.x == 0) tick = __hip_atomic_fetch_add(cnt, 1u, __ATOMIC_RELAXED, __HIP_MEMORY_SCOPE_AGENT);
  }
  __device__ __forceinline__ void next(char* smem) {
    if (!cnt) { e += nb; return; }
    if (threadIdx.x == 0) *(volatile int*)smem = (int)tick + nb;
    __syncthreads();
    e = *(volatile int*)smem;
    __syncthreads();
  }
  __device__ __forceinline__ void next() { e += nb; }
  __device__ __forceinline__ void get(int& tm, int& tn) const {
    const int per = SH * SW, si = e / per, r = e - si * per, s = x + 8 * si;
    const int sg = s / nsc, sc = s - sg * nsc;
    const int rr = r / SW;
    tm = sg * SH + rr; tn = sc * SW + (r - rr * SW);
  }
};
#define TILE_IDS const int tid = otid(), lane = tid & 63, wid = tid >> 6, wr = wid >> 1, wc = wid & 1, fr = lane & 15, fq = lane >> 4

__device__ __forceinline__ void phase_ffn_up(const Params& p, int half, int mrows, char* smem, unsigned* tk) {
  TILE_IDS; (void)tid;
  const bf16_t* H = WS_BF(p, OFF_H);
  const bf16_t* W = WS_BF(p, OFF_W) + W_UP + (size_t)half * 5632 * 1024;
  bf16_t* ACT = WS_BF(p, OFF_P);
  for (TileIter ti(mrows / 128, 44, 8, 11, tk); ti.valid();) {
    int tm, tn; ti.get(tm, tn);
    ti.prefetch();
    f32x4 acc[4][4];
    zero_acc<4>(acc);
    gemm_main<4>(H + (size_t)tm * 128 * DM, DM, W + (size_t)tn * 128 * DM, DM, DM, acc, smem);
    ti.next(smem);
    bf16_t* ob = ACT + (size_t)(tm * 128 + wr * 64 + fr) * DFF + tn * 64 + wc * 32 + fq * 4;
#pragma unroll
    for (int m = 0; m < 4; ++m) {
#pragma unroll
      for (int np = 0; np < 2; ++np) {
        float o[4];
#pragma unroll
        for (int j = 0; j < 4; ++j) o[j] = silu(acc[m][2 * np][j]) * acc[m][2 * np + 1][j];
        u32x2 pk; pk.x = pack2(o[0], o[1]); pk.y = pack2(o[2], o[3]);
        *(u32x2*)(ob + (m * 16) * DFF + np * 16) = pk;
      }
      __builtin_amdgcn_sched_barrier(0);
    }
  }
}

__device__ __forceinline__ void phase_resid_gemm(const Params& p, const bf16_t* A, int lda, const bf16_t* Wt, int K, int l, int gate_k, float scale,
                                 bool from_input, int mrows, char* smem, unsigned* tk) {
  TILE_IDS; (void)tid;
  for (TileIter ti(mrows / 128, 8, 4, 8, tk); ti.valid();) {
    int tm, tn; ti.get(tm, tn);
    ti.prefetch();
    f32x4 acc[4][4];
    zero_acc<4>(acc);
    gemm_main<4>(A + (size_t)tm * 128 * lda, lda, Wt + (size_t)tn * 128 * K, K, K, acc, smem);
    ti.next(smem);
    const int bi = mod_idx(tm * 128);
    const float* gate = mods_ptr(p, l, bi, gate_k);
    const int row0 = tm * 128 + wr * 64 + fr, col0 = tn * 128 + wc * 64 + fq * 4;
    const float* xi = xrow_ptr(p, from_input, row0) + col0;
    float* xo = xrow_out(p, row0) + col0;
    float4 gv[4];
#pragma unroll
    for (int n = 0; n < 4; ++n) {
      gv[n] = *(const float4*)(gate + col0 + n * 16);
      gv[n].x *= scale; gv[n].y *= scale; gv[n].z *= scale; gv[n].w *= scale;
    }
#pragma unroll
    for (int m = 0; m < 4; ++m) {
#pragma unroll
      for (int n = 0; n < 4; ++n) {
        const float4 xv = *(const float4*)(xi + (m * 16) * DM + n * 16);
        float4 ov;
        ov.x = xv.x + gv[n].x * acc[m][n][0];
        ov.y = xv.y + gv[n].y * acc[m][n][1];
        ov.z = xv.z + gv[n].z * acc[m][n][2];
        ov.w = xv.w + gv[n].w * acc[m][n][3];
        *(float4*)(xo + (m * 16) * DM + n * 16) = ov;
      }
      __builtin_amdgcn_sched_barrier(0);
    }
  }
}

__device__ __forceinline__ void phase_win(const Params& p, char* smem, unsigned* tk) {
  TILE_IDS; (void)tid;
  const bf16_t* H = WS_BF(p, OFF_H);
  const bf16_t* W = WS_BF(p, OFF_W) + W_IN;
  bf16_t* P = WS_BF(p, OFF_P);
  for (TileIter ti(NTOK / 128, 25, 8, 5, tk); ti.valid();) {
    int tm, tn; ti.get(tm, tn);
    ti.prefetch();
    f32x4 acc[4][4];
    zero_acc<4>(acc);
    gemm_main<4>(H + (size_t)tm * 128 * DM, DM, W + (size_t)tn * 128 * DM, DM, DM, acc, smem);
    ti.next(smem);
    const int col0 = tn * 128 + wc * 64 + fq * 4;
    bf16_t* ob = P + (size_t)(tm * 128 + wr * 64 + fr) * PC + col0;
#pragma unroll
    for (int m = 0; m < 4; ++m) {
#pragma unroll
      for (int n = 0; n < 4; ++n) {
        if (col0 + n * 16 < PC) {
          u32x2 pk; pk.x = pack2(acc[m][n][0], acc[m][n][1]); pk.y = pack2(acc[m][n][2], acc[m][n][3]);
          *(u32x2*)(ob + (m * 16) * PC + n * 16) = pk;
        }
      }
      __builtin_amdgcn_sched_barrier(0);
    }
  }
}

__device__ __forceinline__ void phase_glu(const Params& p, int mrows, char* smem) {
  TILE_IDS; (void)tid;
  bf16_t* P = WS_BF(p, OFF_P);
  const bf16_t* W = WS_BF(p, OFF_W) + W_GLU;
  for (TileIter ti(mrows / 128, 4, 4, 4); ti.valid(); ti.next()) {
    int tm, tn; ti.get(tm, tn);
    f32x4 acc[4][4];
    zero_acc<4>(acc);
    gemm_main<4>(P + (size_t)tm * 128 * PC + C_S5G, PC, W + (size_t)tn * 128 * 256, 256, 256, acc, smem);
    bf16_t* ob = P + (size_t)(tm * 128 + wr * 64 + fr) * PC + C_YS5 + tn * 64 + wc * 32 + fq * 4;
#pragma unroll
    for (int m = 0; m < 4; ++m) {
#pragma unroll
      for (int np = 0; np < 2; ++np) {
        float o[4];
#pragma unroll
        for (int j = 0; j < 4; ++j) o[j] = acc[m][2 * np][j] * sigm(acc[m][2 * np + 1][j]);
        u32x2 pk; pk.x = pack2(o[0], o[1]); pk.y = pack2(o[2], o[3]);
        *(u32x2*)(ob + (m * 16) * PC + np * 16) = pk;
      }
      __builtin_amdgcn_sched_barrier(0);
    }
  }
}

__device__ __forceinline__ void phase_merge(const Params& p, int mrows, char* smem) {
  TILE_IDS; (void)tid;
  const bf16_t* H = WS_BF(p, OFF_H);
  const bf16_t* P = WS_BF(p, OFF_P);
  const bf16_t* WG = WS_BF(p, OFF_W) + W_GT;
  const bf16_t* WB = WS_BF(p, OFF_W) + W_BT;
  bf16_t* ACC = WS_BF(p, OFF_SC);
  for (TileIter ti(mrows / 128, 16, 4, 8); ti.valid(); ti.next()) {
    int tm, tn; ti.get(tm, tn);
    f32x4 sum[4][2];
    zero_acc<2>(sum);
#pragma unroll 1
    for (int ip = 0; ip < 2; ++ip) {
      const int i0 = 2 * ip;
      f32x4 g[4][4];
      zero_acc<4>(g);
      gemm_main<4, true>(H + (size_t)tm * 128 * DM, DM, WG + ((size_t)i0 * 1024 + tn * 64) * DM, DM, DM, g, smem, 1024, 32);
      u32x2 gp[4][4];
#pragma unroll
      for (int m = 0; m < 4; ++m)
#pragma unroll
        for (int n = 0; n < 4; ++n) {
          gp[m][n].x = pack2(sigm(g[m][n][0]), sigm(g[m][n][1]));
          gp[m][n].y = pack2(sigm(g[m][n][2]), sigm(g[m][n][3]));
        }
      __builtin_amdgcn_sched_barrier(0);
#pragma unroll 1
      for (int q = 0; q < 2; ++q) {
        const int i = i0 + q;
        const int ycol = (i == 0) ? C_YDN : (i == 1) ? C_YS5 : (i == 2) ? C_YHG : C_YAT;
        f32x4 y[4][2];
        zero_acc<2>(y);
        __builtin_amdgcn_sched_barrier(0);
        gemm_main<2, true>(P + (size_t)tm * 128 * PC + ycol, PC, WB + ((size_t)i * 1024 + tn * 64) * 256, 256, 256, y, smem);
        __builtin_amdgcn_sched_barrier(0);
#pragma unroll
        for (int m = 0; m < 4; ++m) {
#pragma unroll
          for (int n = 0; n < 2; ++n)
#pragma unroll
            for (int j = 0; j < 4; ++j) {
              const unsigned wa_ = (j < 2) ? gp[m][n].x : gp[m][n].y;
              const unsigned wb_ = (j < 2) ? gp[m][2 + n].x : gp[m][2 + n].y;
              const unsigned w_ = q ? wb_ : wa_;
              const float gj = (j & 1) ? bfhi(w_) : bflo(w_);
              sum[m][n][j] += gj * y[m][n][j];
            }
          __builtin_amdgcn_sched_barrier(0);
        }
      }
    }
    bf16_t* ob = ACC + (size_t)(tm * 128 + wr * 64 + fr) * DM + tn * 64 + wc * 32 + fq * 4;
#pragma unroll
    for (int m = 0; m < 4; ++m) {
#pragma unroll
      for (int n = 0; n < 2; ++n) {
        u32x2 pk; pk.x = pack2(sum[m][n][0], sum[m][n][1]); pk.y = pack2(sum[m][n][2], sum[m][n][3]);
        *(u32x2*)(ob + (m * 16) * DM + n * 16) = pk;
      }
      __builtin_amdgcn_sched_barrier(0);
    }
  }
}

__device__ __forceinline__ void phase_attn_prep(const Params& p, int l) {
  bf16_t* P = WS_BF(p, OFF_P);
  bf16_t* KP = WS_BF(p, OFF_KP);
  bf16_t* VT = WS_BF(p, OFF_VT);
  const float* qg = p.in[26] + l * 64;
  const float* kg = p.in[27] + l * 64;
  const int total = NTOK * 16;
  const int tidq = otid();
#pragma unroll 1
  for (int idx = blockIdx.x * 256 + tidq; idx < total; idx += gridDim.x * 256) {
    const int hf = idx & 1, it = idx >> 1;
    const int vec = it / NTOK, tok = it - vec * NTOK;
    const bool lat = tok < NLAT;
    const int b = lat ? (tok >> 11) : ((tok - NLAT) >> 8);
    const int pos = lat ? (tok & 2047) : ((tok - NLAT) & 255);
    const int col = (vec < 4 ? C_ATQ + vec * 64 : (vec < 6 ? C_ATK + (vec - 4) * 64 : C_ATV + (vec - 6) * 64)) + hf * 32;
    bf16_t* src = P + (size_t)tok * PC + col;
    u32x4 raw[4];
#pragma unroll
    for (int i = 0; i < 4; ++i) raw[i] = *(const u32x4*)(src + i * 8);
    const int key = lat ? CTXL + pos : pos;
    if (vec < 6) {
      float x[32];
#pragma unroll
      for (int i = 0; i < 4; ++i) {
        x[i * 8 + 0] = bflo(raw[i].x); x[i * 8 + 1] = bfhi(raw[i].x);
        x[i * 8 + 2] = bflo(raw[i].y); x[i * 8 + 3] = bfhi(raw[i].y);
        x[i * 8 + 4] = bflo(raw[i].z); x[i * 8 + 5] = bfhi(raw[i].z);
        x[i * 8 + 6] = bflo(raw[i].w); x[i * 8 + 7] = bfhi(raw[i].w);
      }
      float ss = 0.f;
#pragma unroll
      for (int i = 0; i < 32; ++i) ss += x[i] * x[i];
      ss += __shfl_xor(ss, 1);
      const float rstd = rsqrtf(ss * (1.f / 64.f) + 1e-6f);
      const float* gg = (vec < 4 ? qg : kg) + hf * 32;
#pragma unroll
      for (int i = 0; i < 32; ++i) x[i] = x[i] * rstd * gg[i];
      if (lat) {
        const float ang = hf ? (float)(pos & 63) : (float)(pos >> 6);
#pragma unroll
        for (int i = 0; i < 16; ++i) {
          const float inv = exp2f(-(float)i * (13.287712379549449f / 16.f));
          float s1, c1;
          __sincosf(ang * inv, &s1, &c1);
          const float x1 = x[i], x2 = x[16 + i];
          x[i] = x1 * c1 - x2 * s1;
          x[16 + i] = x2 * c1 + x1 * s1;
        }
      }
      const float qs = (vec < 4) ? 0.125f * 1.4426950408889634f : 1.f;
      bf16_t* dst = (vec < 4) ? src : KP + ((size_t)(b * 2 + (vec - 4)) * TJ + key) * 64 + hf * 32;
#pragma unroll
      for (int i = 0; i < 4; ++i) {
        u32x4 o;
        o.x = pack2(x[i * 8 + 0] * qs, x[i * 8 + 1] * qs);
        o.y = pack2(x[i * 8 + 2] * qs, x[i * 8 + 3] * qs);
        o.z = pack2(x[i * 8 + 4] * qs, x[i * 8 + 5] * qs);
        o.w = pack2(x[i * 8 + 6] * qs, x[i * 8 + 7] * qs);
        *(u32x4*)(dst + i * 8) = o;
      }
    } else {
      const int w = key & 31, ww = w & 15;
      const int slot = (key & ~31) + (ww >> 2) * 8 + (ww & 3) + (w >= 16 ? 4 : 0);
      bf16_t* dst = VT + ((size_t)(b * 2 + (vec - 6)) * 64 + hf * 32) * TJ + slot;
#pragma unroll
      for (int i = 0; i < 4; ++i) {
        dst[(size_t)(i * 8 + 0) * TJ] = (bf16_t)(raw[i].x & 0xffff); dst[(size_t)(i * 8 + 1) * TJ] = (bf16_t)(raw[i].x >> 16);
        dst[(size_t)(i * 8 + 2) * TJ] = (bf16_t)(raw[i].y & 0xffff); dst[(size_t)(i * 8 + 3) * TJ] = (bf16_t)(raw[i].y >> 16);
        dst[(size_t)(i * 8 + 4) * TJ] = (bf16_t)(raw[i].z & 0xffff); dst[(size_t)(i * 8 + 5) * TJ] = (bf16_t)(raw[i].z >> 16);
        dst[(size_t)(i * 8 + 6) * TJ] = (bf16_t)(raw[i].w & 0xffff); dst[(size_t)(i * 8 + 7) * TJ] = (bf16_t)(raw[i].w >> 16);
      }
    }
  }
}

using f32x2 = __attribute__((ext_vector_type(2))) float;
__device__ __forceinline__ f32x2 mk2(float a, float b) { f32x2 r; r.x = a; r.y = b; return r; }

__device__ __forceinline__ void dn_task(const Params& p, int l, int task, char* smem) {
  const int tid = otid();
  const int dir = task & 1, hd = (task >> 1) & 3, vh = (task >> 3) & 1, b = task >> 4;
  float* qs = (float*)smem;
  float* ks = qs + 32 * 68;
  float* vs = ks + 32 * 68;
  float* al = vs + 32 * 64;
  float* dots = al + 64;
  float* wl = al + 128;
  bf16_t* rawb = (bf16_t*)(wl + 5 * 192);
  const bf16_t* P = WS_BF(p, OFF_P);
  const float* cw = p.in[11] + (size_t)l * 5 * 768;
  const float Aexp = __expf(p.in[12][l * 8 + dir * 4 + hd]);
  const float dtb = p.in[13][l * 8 + dir * 4 + hd];
  bf16_t* O = WS_BF(p, OFF_SC) + (size_t)dir * NTOK * 256;
  const int v = vh * 32 + (tid >> 3), kq = tid & 7;
  for (int i = tid; i < 5 * 192; i += 256) {
    const int j = i / 192, c = i - j * 192;
    wl[i] = cw[j * 768 + (c >> 6) * 256 + hd * 64 + (c & 63)];
  }
  float ra = 0.f, rb = 0.f;
  f32x2 S2[4];
#pragma unroll
  for (int i = 0; i < 4; ++i) S2[i] = mk2(0.f, 0.f);
#define OCT_SUM(x_)                                                                                   \
  {                                                                                                   \
    x_ += __int_as_float(__builtin_amdgcn_update_dpp(0, __float_as_int(x_), 0xB1, 0xF, 0xF, true));   \
    x_ += __int_as_float(__builtin_amdgcn_update_dpp(0, __float_as_int(x_), 0x4E, 0xF, 0xF, true));   \
    x_ += __int_as_float(__builtin_amdgcn_update_dpp(0, __float_as_int(x_), 0x141, 0xF, 0xF, true));  \
  }

#define DN_PREFETCH(n_)                                                                                        \
  {                                                                                                            \
    const bool isctx_ = (n_) < 8;                                                                              \
    const int len_ = isctx_ ? CTXL : SEQL, sb_ = (isctx_ ? (n_) : (n_) - 8) * 32;                              \
    const int rowb_ = isctx_ ? NLAT + b * CTXL : b * SEQL;                                                     \
    const int plo_ = dir ? (len_ - 32 - sb_) : sb_;                                                            \
    _Pragma("unroll") for (int i = 0; i < 4; ++i) {                                                            \
      const int id_ = tid + 256 * i;                                                                           \
      if (id_ < 864) {                                                                                         \
        const int r_ = id_ / 24, cc_ = id_ - r_ * 24;                                                          \
        int pos_ = plo_ - 2 + r_;                                                                              \
        pos_ = pos_ < 0 ? 0 : (pos_ > len_ - 1 ? len_ - 1 : pos_);                                             \
        __builtin_amdgcn_global_load_lds(                                                                      \
            (const unsigned*)(P + (size_t)(rowb_ + pos_) * PC + C_DNQKV + (cc_ >> 3) * 256 + hd * 64 + (cc_ & 7) * 8), \
            (unsigned*)((char*)rawb + id_ * 16), 16, 0, 0);                                                    \
      }                                                                                                        \
    }                                                                                                          \
    if (tid >= 224) {                                                                                          \
      const int t_ = tid - 224, pos_ = dir ? (plo_ + 31 - t_) : (plo_ + t_);                                   \
      const bf16_t* pr_ = P + (size_t)(rowb_ + pos_) * PC;                                                     \
      ra = bf2f(pr_[C_DNA + dir * 4 + hd]);                                                                    \
      rb = bf2f(pr_[C_DNB + dir * 4 + hd]);                                                                    \
    }                                                                                                          \
  }

  DN_PREFETCH(0);
  asm volatile("s_waitcnt vmcnt(0)" ::: "memory");
  __syncthreads();
#pragma unroll 1
  for (int n = 0; n < 72; ++n) {
    const bool isctx = n < 8;
    const int len = isctx ? CTXL : SEQL;
    const int sbase = (isctx ? n : n - 8) * 32;
    const int rowbase = isctx ? NLAT + b * CTXL : b * SEQL;
    const int plo = dir ? (len - 32 - sbase) : sbase;
    if (tid < 192) {
      const int c4 = tid % 48, tg = tid / 48, part = c4 >> 4, cc = (c4 & 15) * 4;
      float4 w[5];
#pragma unroll
      for (int j = 0; j < 5; ++j) w[j] = *(const float4*)(wl + j * 192 + c4 * 4);
      float x0[12], x1[12], x2[12], x3[12];
#pragma unroll
      for (int r = 0; r < 12; ++r) {
        const int pp = plo + tg * 8 + r - 2;
        u32x2 rr = *(const u32x2*)(rawb + (tg * 8 + r) * 192 + c4 * 4);
        const bool ok = (pp >= 0) && (pp < len);
        rr.x = ok ? rr.x : 0u; rr.y = ok ? rr.y : 0u;
        x0[r] = bflo(rr.x); x1[r] = bfhi(rr.x); x2[r] = bflo(rr.y); x3[r] = bfhi(rr.y);
      }
      float* dbase = (part == 0) ? (qs + cc) : (part == 1) ? (ks + cc) : (vs + cc);
      const int dstride = (part == 2) ? 64 : 68;
#pragma unroll
      for (int uu = 0; uu < 8; ++uu) {
        float a0 = 0.f, a1 = 0.f, a2 = 0.f, a3 = 0.f;
#pragma unroll
        for (int j = 0; j < 5; ++j) {
          a0 += w[j].x * x0[uu + j]; a1 += w[j].y * x1[uu + j]; a2 += w[j].z * x2[uu + j]; a3 += w[j].w * x3[uu + j];
        }
        const int u = tg * 8 + uu, t = dir ? 31 - u : u;
        float4 o4; o4.x = silu(a0); o4.y = silu(a1); o4.z = silu(a2); o4.w = silu(a3);
        *(float4*)(dbase + t * dstride) = o4;
      }
    }
    if (tid >= 224) {
      const int t = tid - 224;
      const float xx = ra + dtb;
      const float sp = xx > 20.f ? xx : log1pf(__expf(xx));
      al[t] = __expf(-Aexp * sp);
      al[32 + t] = sigm(rb);
    }
    __syncthreads();
    {
      const int r = tid >> 2, pt = tid & 3;
      float* qp = (r < 32 ? qs + r * 68 : ks + (r - 32) * 68) + pt * 16;
      float s = 0.f;
#pragma unroll
      for (int i = 0; i < 16; ++i) s += qp[i] * qp[i];
      s = quad_sum(s);
      const float scq = rsqrtf(s + 1e-6f) * (r < 32 ? 0.125f : 1.f);
#pragma unroll
      for (int i = 0; i < 16; ++i) qp[i] *= scq;
    }
    __syncthreads();
    if (n + 1 < 72) DN_PREFETCH(n + 1);

    {
      const int did = tid >> 2, pp = did >> 2, wh = did & 3, part = tid & 3;
      const float* xr = (wh == 0) ? (ks + (2 * pp + 1) * 68) : (wh == 1) ? (qs + (2 * pp) * 68) : (qs + (2 * pp + 1) * 68);
      const float* yr = (wh == 3) ? (ks + (2 * pp + 1) * 68) : (ks + (2 * pp) * 68);
      float sdot = 0.f;
#pragma unroll
      for (int i = 0; i < 16; ++i) sdot += xr[part * 16 + i] * yr[part * 16 + i];
      sdot = quad_sum(sdot);
      if (part == 0) dots[did] = sdot;
    }
    __syncthreads();
#define DN_LD2(p_, K0_, K1_, Q0_, Q1_, AB_, VV_, DT_)                                \
  {                                                                                 \
    const int t_ = 2 * (p_);                                                        \
    _Pragma("unroll") for (int i = 0; i < 2; ++i) {                                 \
      K0_[i] = *(const float4*)(ks + t_ * 68 + kq * 8 + i * 4);                     \
      K1_[i] = *(const float4*)(ks + (t_ + 1) * 68 + kq * 8 + i * 4);               \
      Q0_[i] = *(const float4*)(qs + t_ * 68 + kq * 8 + i * 4);                     \
      Q1_[i] = *(const float4*)(qs + (t_ + 1) * 68 + kq * 8 + i * 4);               \
    }                                                                               \
    AB_.x = al[t_]; AB_.y = al[t_ + 1]; AB_.z = al[32 + t_]; AB_.w = al[33 + t_];   \
    VV_.x = vs[t_ * 64 + v]; VV_.y = vs[(t_ + 1) * 64 + v];                         \
    DT_ = *(const float4*)(dots + 4 * (p_));                                        \
  }
#define DN_PAIR(p_, K0_, K1_, Q0_, Q1_, AB_, VV_, DT_)                               \
  {                                                                                 \
    f32x2 k0[4], k1[4], q0[4], q1[4];                                               \
    _Pragma("unroll") for (int i = 0; i < 2; ++i) {                                 \
      k0[2 * i] = mk2(K0_[i].x, K0_[i].y); k0[2 * i + 1] = mk2(K0_[i].z, K0_[i].w); \
      k1[2 * i] = mk2(K1_[i].x, K1_[i].y); k1[2 * i + 1] = mk2(K1_[i].z, K1_[i].w); \
      q0[2 * i] = mk2(Q0_[i].x, Q0_[i].y); q0[2 * i + 1] = mk2(Q0_[i].z, Q0_[i].w); \
      q1[2 * i] = mk2(Q1_[i].x, Q1_[i].y); q1[2 * i + 1] = mk2(Q1_[i].z, Q1_[i].w); \
    }                                                                               \
    f32x2 ra = k0[0] * S2[0], rb2 = k1[0] * S2[0], re0 = q0[0] * S2[0], re1 = q1[0] * S2[0]; \
    _Pragma("unroll") for (int i = 1; i < 4; ++i) {                                 \
      ra += k0[i] * S2[i]; rb2 += k1[i] * S2[i]; re0 += q0[i] * S2[i]; re1 += q1[i] * S2[i]; \
    }                                                                               \
    float a_ = ra.x + ra.y, b_ = rb2.x + rb2.y, e0_ = re0.x + re0.y, e1_ = re1.x + re1.y; \
    OCT_SUM(a_); OCT_SUM(b_); OCT_SUM(e0_); OCT_SUM(e1_);                           \
    const float al0 = AB_.x, al1 = AB_.y, be0 = AB_.z, be1 = AB_.w;                 \
    const float d0 = be0 * (VV_.x - al0 * a_);                                      \
    const float kS1 = al0 * b_ + DT_.x * d0;                                        \
    const float d1 = be1 * (VV_.y - al1 * kS1);                                     \
    const float o0 = al0 * e0_ + DT_.y * d0;                                        \
    const float a01 = al0 * al1, c0 = al1 * d0;                                     \
    const float o1 = a01 * e1_ + al1 * DT_.z * d0 + DT_.w * d1;                     \
    const f32x2 a012 = mk2(a01, a01), c02 = mk2(c0, c0), d12 = mk2(d1, d1);         \
    _Pragma("unroll") for (int i = 0; i < 4; ++i) S2[i] = a012 * S2[i] + (c02 * k0[i] + d12 * k1[i]); \
    if (kq == 0) { vs[(2 * (p_)) * 64 + v] = o0; vs[(2 * (p_) + 1) * 64 + v] = o1; } \
  }
    {
      float4 k0A[2], k1A[2], q0A[2], q1A[2], abA, dtA; float2 vvA;
      float4 k0B[2], k1B[2], q0B[2], q1B[2], abB, dtB; float2 vvB;
      DN_LD2(0, k0A, k1A, q0A, q1A, abA, vvA, dtA);
#pragma unroll 1
      for (int pp = 0; pp < 16; pp += 2) {
        DN_LD2(pp + 1, k0B, k1B, q0B, q1B, abB, vvB, dtB);
        DN_PAIR(pp, k0A, k1A, q0A, q1A, abA, vvA, dtA);
        const int p2 = (pp + 2 < 16) ? pp + 2 : 15;
        DN_LD2(p2, k0A, k1A, q0A, q1A, abA, vvA, dtA);
        DN_PAIR(pp + 1, k0B, k1B, q0B, q1B, abB, vvB, dtB);
      }
    }
    asm volatile("s_waitcnt vmcnt(0)" ::: "memory");
    __syncthreads();
    {
      const int t = tid >> 3, pt = tid & 7;
      const int pos = dir ? (plo + 31 - t) : (plo + t);
      const float* op = vs + t * 64 + vh * 32 + pt * 4;
      u32x2 o0;
      o0.x = pack2(op[0], op[1]); o0.y = pack2(op[2], op[3]);
      *(u32x2*)(O + (size_t)(rowbase + pos) * 256 + hd * 64 + vh * 32 + pt * 4) = o0;
    }
    __syncthreads();
  }
}

__device__ __forceinline__ void hg_task(const Params& p, int l, int task, char* smem) {
  const int tid = otid(), lane = tid & 63, wid = tid >> 6;
  const int dir = task & 1, hd = (task >> 1) & 3, b = task >> 3;
  float* qs = (float*)smem;
  float* fs = qs + 64 * 68;
  float* vs = fs + 64 * 68;
  const bf16_t* P = WS_BF(p, OFF_P);
  bf16_t* O = WS_BF(p, OFF_SC) + (size_t)(2 + dir) * NTOK * 256;
  const int v = wid * 16 + (lane >> 2), kq = lane & 3;
  const int cc = (tid & 15) * 4, t0 = tid >> 4;
  float lb[4];
#pragma unroll
  for (int e = 0; e < 4; ++e) {
    const int c = hd * 64 + cc + e;
    lb[e] = (l == 0) ? 0.f : sigm(p.in[24][256 + c] - p.in[24][c]);
  }
  u32x2 rq[4], rf[4], rv[4];
  f32x2 S2[8];
#pragma unroll
  for (int i = 0; i < 8; ++i) S2[i] = mk2(0.f, 0.f);

#define HG_PREFETCH(n_)                                                                       \
  {                                                                                           \
    const bool isctx_ = (n_) < 4;                                                             \
    const int len_ = isctx_ ? CTXL : SEQL, sb_ = (isctx_ ? (n_) : (n_) - 4) * 64;             \
    const int rowb_ = isctx_ ? NLAT + b * CTXL : b * SEQL;                                    \
    const int plo_ = dir ? (len_ - 64 - sb_) : sb_;                                           \
    _Pragma("unroll") for (int i = 0; i < 4; ++i) {                                           \
      const int t_ = t0 + 16 * i, pos_ = dir ? (plo_ + 63 - t_) : (plo_ + t_);                \
      const bf16_t* pr_ = P + (size_t)(rowb_ + pos_) * PC;                                    \
      rq[i] = *(const u32x2*)(pr_ + C_HGQ + hd * 64 + cc);                                    \
      rf[i] = *(const u32x2*)(pr_ + C_HGF + dir * 256 + hd * 64 + cc);                        \
      rv[i] = *(const u32x2*)(pr_ + C_HGV + hd * 64 + cc);                                    \
    }                                                                                         \
  }

  HG_PREFETCH(0);
#pragma unroll 1
  for (int n = 0; n < 36; ++n) {
    const bool isctx = n < 4;
    const int len = isctx ? CTXL : SEQL;
    const int sbase = (isctx ? n : n - 4) * 64;
    const int rowbase = isctx ? NLAT + b * CTXL : b * SEQL;
    const int plo = dir ? (len - 64 - sbase) : sbase;
#pragma unroll
    for (int i = 0; i < 4; ++i) {
      const int t = t0 + 16 * i;
      float4 q4, f4, v4;
      q4.x = silu(bflo(rq[i].x)); q4.y = silu(bfhi(rq[i].x)); q4.z = silu(bflo(rq[i].y)); q4.w = silu(bfhi(rq[i].y));
      f4.x = fmaxf(lb[0] + (1.f - lb[0]) * sigm(bflo(rf[i].x)), 1e-30f);
      f4.y = fmaxf(lb[1] + (1.f - lb[1]) * sigm(bfhi(rf[i].x)), 1e-30f);
      f4.z = fmaxf(lb[2] + (1.f - lb[2]) * sigm(bflo(rf[i].y)), 1e-30f);
      f4.w = fmaxf(lb[3] + (1.f - lb[3]) * sigm(bfhi(rf[i].y)), 1e-30f);
      v4.x = bflo(rv[i].x); v4.y = bfhi(rv[i].x); v4.z = bflo(rv[i].y); v4.w = bfhi(rv[i].y);
      *(float4*)(qs + t * 68 + cc) = q4;
      *(float4*)(fs + t * 68 + cc) = f4;
      *(float4*)(vs + t * 64 + cc) = v4;
    }
    __syncthreads();
    if (n + 1 < 36) HG_PREFETCH(n + 1);

#define HG_LD(t_, F_, Q_, V_)                                                       \
  {                                                                                 \
    _Pragma("unroll") for (int i = 0; i < 4; ++i) {                                 \
      F_[i] = *(const float4*)(fs + (t_) * 68 + kq * 16 + i * 4);                   \
      Q_[i] = *(const float4*)(qs + (t_) * 68 + kq * 16 + i * 4);                   \
    }                                                                               \
    V_ = vs[(t_) * 64 + v];                                                         \
  }
#define HG_STEP(t_, F_, Q_, V_)                                                     \
  {                                                                                 \
    f32x2 f2[8], q2[8];                                                             \
    _Pragma("unroll") for (int i = 0; i < 4; ++i) {                                 \
      f2[2 * i] = mk2(F_[i].x, F_[i].y); f2[2 * i + 1] = mk2(F_[i].z, F_[i].w);     \
      q2[2 * i] = mk2(Q_[i].x, Q_[i].y); q2[2 * i + 1] = mk2(Q_[i].z, Q_[i].w);     \
    }                                                                               \
    const f32x2 v2 = mk2(V_, V_);                                                   \
    _Pragma("unroll") for (int i = 0; i < 8; ++i) S2[i] = f2[i] * (S2[i] - v2) + v2; \
    f32x2 oa = q2[0] * S2[0], ob = q2[1] * S2[1];                                   \
    oa += q2[2] * S2[2]; ob += q2[3] * S2[3];                                       \
    oa += q2[4] * S2[4]; ob += q2[5] * S2[5];                                       \
    oa += q2[6] * S2[6]; ob += q2[7] * S2[7];                                       \
    const float o = quad_sum((oa.x + oa.y) + (ob.x + ob.y));                        \
    if (kq == 0) vs[(t_) * 64 + v] = o;                                             \
  }
    {
      float4 fA[4], qA[4], fB[4], qB[4];
      float vA, vB;
      HG_LD(0, fA, qA, vA);
#pragma unroll 1
      for (int t = 0; t < 64; t += 2) {
        HG_LD(t + 1, fB, qB, vB);
        HG_STEP(t, fA, qA, vA);
        const int t2 = (t + 2 < 64) ? t + 2 : 63;
        HG_LD(t2, fA, qA, vA);
        HG_STEP(t + 1, fB, qB, vB);
      }
    }
    __syncthreads();
    {
      const int t = tid >> 2, pt = tid & 3;
      const int pos = dir ? (plo + 63 - t) : (plo + t);
      const float* op = vs + t * 64 + pt * 16;
      u32x4 o0, o1;
      o0.x = pack2(op[0], op[1]); o0.y = pack2(op[2], op[3]); o0.z = pack2(op[4], op[5]); o0.w = pack2(op[6], op[7]);
      o1.x = pack2(op[8], op[9]); o1.y = pack2(op[10], op[11]); o1.z = pack2(op[12], op[13]); o1.w = pack2(op[14], op[15]);
      bf16_t* dst = O + (size_t)(rowbase + pos) * 256 + hd * 64 + pt * 16;
      *(u32x4*)dst = o0;
      *(u32x4*)(dst + 8) = o1;
    }
    __syncthreads();
  }
}

__device__ __forceinline__ void s5_task(const Params& p, int l, int task, char* smem) {
  const int tid = otid(), lane = tid & 63, wid = tid >> 6, fr = lane & 15, fq = lane >> 4;
  const int dir = task & 1, gq = (task >> 1) & 3, b = task >> 3, g = gq * 4 + wid;
  float* U = (float*)(smem + wid * 8704);
  bf16_t* Hs = (bf16_t*)(smem + wid * 8704 + 4096);
  const bf16_t* P = WS_BF(p, OFF_P);
  bf16_t* Y = WS_BF(p, OFF_SC) + (size_t)(4 + dir) * NTOK * 256;
  const int li = (l * 2 + dir) * 16 + g;
  const float lr = p.in[15][li * 64 + lane], lim = p.in[16][li * 64 + lane];
  const float st = expf(p.in[17][li]);
  const float mag = expf(lr * st);
  float sn, cs;
  sincosf(lim * st, &sn, &cs);
  const float are = mag * cs, aim = mag * sn;
  const float den = lr * lr + lim * lim, nre = are - 1.f;
  const float cre = (nre * lr + aim * lim) / den, cim = (aim * lr - nre * lim) / den;
  f32x2 bb[16];
  {
    const float* br = p.in[18] + ((size_t)(l * 16 + g) * 64 + lane) * 16;
    const float* bi = p.in[19] + ((size_t)(l * 16 + g) * 64 + lane) * 16;
#pragma unroll
    for (int h = 0; h < 16; ++h) {
      const float r_ = br[h], i_ = bi[h];
      bb[h] = mk2(cre * r_ - cim * i_, cre * i_ + cim * r_);
    }
  }
  bf16x8 cB[4];
  {
    const float* cr = p.in[20] + ((size_t)(l * 16 + g) * 16 + fr) * 64;
    const float* ci = p.in[21] + ((size_t)(l * 16 + g) * 16 + fr) * 64;
#pragma unroll
    for (int ks = 0; ks < 4; ++ks)
#pragma unroll
      for (int j = 0; j < 8; ++j) {
        const int K = 32 * ks + fq * 8 + j, pp = K >> 1;
        const float val = (K & 1) ? -ci[pp] : cr[pp];
        cB[ks][j] = (short)f2bf(val);
      }
  }
  f32x2 hh = mk2(0.f, 0.f);
  const f32x2 are2 = mk2(are, are), aim2 = mk2(-aim, aim);
  u32x4 r0, r1;
  {
    const u32x4* src = (const u32x4*)(P + (size_t)seq_row(b, dir, lane) * PC + C_S5U + g * 16);
    r0 = src[0]; r1 = src[1];
  }
#pragma unroll 1
  for (int n = 0; n < 36; ++n) {
    {
      float4* ud = (float4*)(U + lane * 16);
      ud[0] = float4{bflo(r0.x), bfhi(r0.x), bflo(r0.y), bfhi(r0.y)};
      ud[1] = float4{bflo(r0.z), bfhi(r0.z), bflo(r0.w), bfhi(r0.w)};
      ud[2] = float4{bflo(r1.x), bfhi(r1.x), bflo(r1.y), bfhi(r1.y)};
      ud[3] = float4{bflo(r1.z), bfhi(r1.z), bflo(r1.w), bfhi(r1.w)};
    }
    if (n + 1 < 36) {
      const u32x4* src = (const u32x4*)(P + (size_t)seq_row(b, dir, (n + 1) * 64 + lane) * PC + C_S5U + g * 16);
      r0 = src[0]; r1 = src[1];
    }
#define S5_LD(t_, U_)  { _Pragma("unroll") for (int i = 0; i < 4; ++i) U_[i] = *(const float4*)(U + (t_) * 16 + i * 4); }
#define S5_STEP(tt_, U_)                                                                      \
  {                                                                                           \
    f32x2 x0 = bb[0] * U_[0].x, x1 = bb[1] * U_[0].y, x2 = bb[2] * U_[0].z, x3 = bb[3] * U_[0].w; \
    x0 += bb[4] * U_[1].x; x1 += bb[5] * U_[1].y; x2 += bb[6] * U_[1].z; x3 += bb[7] * U_[1].w;  \
    x0 += bb[8] * U_[2].x; x1 += bb[9] * U_[2].y; x2 += bb[10] * U_[2].z; x3 += bb[11] * U_[2].w; \
    x0 += bb[12] * U_[3].x; x1 += bb[13] * U_[3].y; x2 += bb[14] * U_[3].z; x3 += bb[15] * U_[3].w; \
    const f32x2 xs = (x0 + x1) + (x2 + x3);                                                   \
    const f32x2 hsw = mk2(hh.y, hh.x);                                                        \
    hh = are2 * hh + (aim2 * hsw + xs);                                                       \
    *(unsigned*)(Hs + (tt_) * 136 + 2 * lane) = pack2(hh.x, hh.y);                            \
  }
#pragma unroll 1
    for (int sub = 0; sub < 4; ++sub) {
      float4 uA[4], uB[4];
      S5_LD(sub * 16, uA);
#pragma unroll
      for (int tt = 0; tt < 16; tt += 2) {
        S5_LD(sub * 16 + tt + 1, uB);
        S5_STEP(tt, uA);
        if (tt + 2 < 16) S5_LD(sub * 16 + tt + 2, uA);
        S5_STEP(tt + 1, uB);
      }
      f32x4 y = {0.f, 0.f, 0.f, 0.f};
#pragma unroll
      for (int ks = 0; ks < 4; ++ks) {
        const bf16x8 a = *(const bf16x8*)(Hs + fr * 136 + 32 * ks + fq * 8);
        y = __builtin_amdgcn_mfma_f32_16x16x32_bf16(cB[ks], a, y, 0, 0, 0);
      }
      {
        const int row = seq_row(b, dir, n * 64 + sub * 16 + fr);
        u32x2 pk; pk.x = pack2(y[0], y[1]); pk.y = pack2(y[2], y[3]);
        *(u32x2*)(Y + (size_t)row * 256 + g * 16 + fq * 4) = pk;
      }
    }
  }
}

__device__ __forceinline__ void attn_task(const Params& p, int l, int task, bool isctx, char* smem) {
  const int tid = otid(), lane = tid & 63, wid = tid >> 6, fr = lane & 15, fq = lane >> 4;
  int qt, kvh, b, nkt;
  if (!isctx) { qt = task & 31; kvh = (task >> 5) & 1; b = task >> 6; nkt = 36; }
  else { qt = task & 3; kvh = (task >> 2) & 1; b = task >> 3; nkt = 4; }
  bf16_t* P = WS_BF(p, OFF_P);
  const int rowq = (isctx ? NLAT + b * CTXL : b * SEQL) + qt * 64 + wid * 16 + fr;
  bf16x8 qB[2][2];
#pragma unroll
  for (int g = 0; g < 2; ++g)
#pragma unroll
    for (int ks = 0; ks < 2; ++ks) qB[g][ks] = *(const bf16x8*)(P + (size_t)rowq * PC + C_ATQ + (kvh * 2 + g) * 64 + ks * 32 + fq * 8);
  const bf16_t* Kg = WS_BF(p, OFF_KP) + (size_t)(b * 2 + kvh) * TJ * 64;
  const bf16_t* Vg = WS_BF(p, OFF_VT) + (size_t)(b * 2 + kvh) * 64 * TJ;
  const int o0 = tid * 16;
  const int lrow = (o0 >> 10) * 8 + ((o0 >> 7) & 7), lcol = ((((o0 >> 4) & 7) ^ ((lrow >> 1) & 7))) * 8;
  const int inner = frag_off(fr, fq);
  const bf16_t* kgl = Kg + (size_t)lrow * 64 + lcol;
  const bf16_t* vgl = Vg + (size_t)lrow * TJ + lcol;
#define AT_ISSUE(kt0_, base_)                                                                                                \
  {                                                                                                                          \
    _Pragma("unroll") for (int h_ = 0; h_ < 2; ++h_) {                                                                       \
      const int tl_ = (kt0_) + h_;                                                                                           \
      _Pragma("unroll") for (int i = 0; i < 2; ++i) {                                                                        \
        __builtin_amdgcn_global_load_lds((const unsigned*)(kgl + (size_t)(tl_ * 64 + 32 * i) * 64),                          \
                                         (unsigned*)(smem + (base_) + h_ * 16384 + i * 4096 + o0), 16, 0, 0);                \
        __builtin_amdgcn_global_load_lds((const unsigned*)(vgl + (size_t)(32 * i) * TJ + tl_ * 64),                          \
                                         (unsigned*)(smem + (base_) + h_ * 16384 + 8192 + i * 4096 + o0), 16, 0, 0);         \
      }                                                                                                                      \
    }                                                                                                                        \
  }
  AT_ISSUE(0, 0);
  asm volatile("s_waitcnt vmcnt(0)" ::: "memory");
  __builtin_amdgcn_s_barrier();
  float gqm = fabsf(p.in[26][l * 64 + lane]), gkm = fabsf(p.in[27][l * 64 + lane]);
#pragma unroll
  for (int o = 32; o >= 1; o >>= 1) { gqm = fmaxf(gqm, __shfl_xor(gqm, o)); gkm = fmaxf(gkm, __shfl_xor(gkm, o)); }
  const float Bsh = 1.02f * (0.125f * 1.4426950408889634f * 64.f) * gqm * gkm;
  float lsum[2] = {0.f, 0.f};
  f32x4 O[4][2];
  zero_acc<2>(O);
  for (int kt = 0; kt < nkt; kt += 2) {
    const int base = ((kt >> 1) & 1) * 32768;
    if (kt + 2 < nkt) AT_ISSUE(kt + 2, 32768 - base);
    __builtin_amdgcn_sched_barrier(0);
#pragma unroll 1
    for (int hh = 0; hh < 2; ++hh) {
    const int cur = base + hh * 16384;
    f32x4 s[4][2];
#pragma unroll
    for (int i = 0; i < 4; ++i)
#pragma unroll
      for (int g = 0; g < 2; ++g) s[i][g] = f32x4{-Bsh, -Bsh, -Bsh, -Bsh};
    __builtin_amdgcn_s_setprio(1);
#pragma unroll
    for (int i = 0; i < 4; ++i)
#pragma unroll
      for (int ks = 0; ks < 2; ++ks) {
        const bf16x8 kf = *(const bf16x8*)(smem + cur + ((i * 2048 + inner) ^ (ks * 64)));
#pragma unroll
        for (int g = 0; g < 2; ++g) s[i][g] = __builtin_amdgcn_mfma_f32_16x16x32_bf16(kf, qB[g][ks], s[i][g], 0, 0, 0);
      }
    __builtin_amdgcn_s_setprio(0);
    __builtin_amdgcn_sched_barrier(0);
    bf16x8 pB[2][2];
#pragma unroll
    for (int g = 0; g < 2; ++g) {
      float ps = 0.f;
#pragma unroll
      for (int i = 0; i < 4; ++i)
#pragma unroll
        for (int j = 0; j < 4; ++j) { const float pv = __builtin_amdgcn_exp2f(s[i][g][j]); s[i][g][j] = pv; ps += pv; }
      lsum[g] += ps;
#pragma unroll
      for (int ii = 0; ii < 2; ++ii) {
        union { u32x4 u; bf16x8 v; } cv;
        cv.u.x = pack2(s[2 * ii][g][0], s[2 * ii][g][1]);
        cv.u.y = pack2(s[2 * ii][g][2], s[2 * ii][g][3]);
        cv.u.z = pack2(s[2 * ii + 1][g][0], s[2 * ii + 1][g][1]);
        cv.u.w = pack2(s[2 * ii + 1][g][2], s[2 * ii + 1][g][3]);
        pB[g][ii] = cv.v;
      }
    }
    __builtin_amdgcn_sched_barrier(0);
    __builtin_amdgcn_s_setprio(1);
#pragma unroll
    for (int mt = 0; mt < 4; ++mt)
#pragma unroll
      for (int ii = 0; ii < 2; ++ii) {
        const bf16x8 vf = *(const bf16x8*)(smem + cur + 8192 + ((mt * 2048 + inner) ^ (ii * 64)));
#pragma unroll
        for (int g = 0; g < 2; ++g) O[mt][g] = __builtin_amdgcn_mfma_f32_16x16x32_bf16(vf, pB[g][ii], O[mt][g], 0, 0, 0);
      }
    __builtin_amdgcn_s_setprio(0);
    }
    __builtin_amdgcn_sched_barrier(0);
    asm volatile("s_waitcnt vmcnt(0)" ::: "memory");
    __builtin_amdgcn_s_barrier();
  }
#undef AT_ISSUE
#pragma unroll
  for (int g = 0; g < 2; ++g) {
    float ls = lsum[g];
    ls += __shfl_xor(ls, 16);
    ls += __shfl_xor(ls, 32);
    const float inv = 1.f / ls;
#pragma unroll
    for (int mt = 0; mt < 4; ++mt) {
      u32x2 o;
      o.x = pack2(O[mt][g][0] * inv, O[mt][g][1] * inv);
      o.y = pack2(O[mt][g][2] * inv, O[mt][g][3] * inv);
      *(u32x2*)(P + (size_t)rowq * PC + C_YAT + (kvh * 2 + g) * 64 + mt * 16 + fq * 4) = o;
    }
  }
}

__device__ __forceinline__ void phase_mixers(const Params& p, int l, char* smem, bool scans_only) {
  int* s_taskp = (int*)smem;
  int* ctr = (int*)(p.ws + OFF_CTR) + l + (scans_only ? 2 : 0);
  const int n_dn = 256, n_hg = 128, n_s5 = 128, n_al = 1024, n_ac = (l == 0) ? 128 : 0;
  const int n_scan = n_dn + n_hg + n_s5;
  const int total = scans_only ? n_scan : (n_scan + n_al + n_ac);
  const bool full = (gridDim.x >= 512);
  int first = -1;
  if (full) {
    const int bx = blockIdx.x;
    if (bx < 512) first = bx;
  }
  for (int it = 0;; ++it) {
    int t;
    if (it == 0 && first >= 0) t = first;
    else {
      if (otid() == 0) *s_taskp = atomicAdd(ctr, 1) + (full ? n_scan : 0);
      __syncthreads();
      t = *s_taskp;
      __syncthreads();
    }
    if (t >= total) break;
    if (t < n_dn) dn_task(p, l, t, smem);
    else if (t < n_dn + n_hg) hg_task(p, l, t - n_dn, smem);
    else if (t < n_scan) s5_task(p, l, t - n_dn - n_hg, smem);
    else { const bool ic = t >= n_scan + n_al; attn_task(p, l, t - n_scan - (ic ? n_al : 0), ic, smem); }
    __syncthreads();
  }
}

__device__ __forceinline__ float sum16(float v) {
  v += __shfl_xor(v, 1); v += __shfl_xor(v, 2); v += __shfl_xor(v, 4); v += __shfl_xor(v, 8);
  return v;
}
__device__ __forceinline__ void phase_postmix(const Params& p, int l, int nrows) {
  bf16_t* P = WS_BF(p, OFF_P);
  const bf16_t* SC = WS_BF(p, OFF_SC);
  const int tidq = otid(); const int lane = tidq & 63, c0 = lane * 4, hc = c0 & 63;
  const float4 gdn = *(const float4*)(p.in[14] + l * 64 + hc);
  const float4 ghg = *(const float4*)(p.in[25] + l * 64 + hc);
  const float4 dsk = *(const float4*)(p.in[22] + l * 256 + c0);
  for (int r = blockIdx.x * 4 + (tidq >> 6); r < nrows; r += gridDim.x * 4) {
    bf16_t* pr = P + (size_t)r * PC;
    const size_t so = (size_t)r * 256 + c0;
    const size_t st = (size_t)NTOK * 256;
    {
      const u32x2 a = *(const u32x2*)(SC + so), bq = *(const u32x2*)(SC + st + so);
      const float o0 = bflo(a.x) + bflo(bq.x), o1 = bfhi(a.x) + bfhi(bq.x), o2 = bflo(a.y) + bflo(bq.y), o3 = bfhi(a.y) + bfhi(bq.y);
      const float ss = sum16(o0 * o0 + o1 * o1 + o2 * o2 + o3 * o3);
      const float rstd = rsqrtf(ss * (1.f / 64.f) + 1e-6f);
      const u32x2 z = *(const u32x2*)(pr + C_DNZ + c0);
      u32x2 o;
      o.x = pack2(o0 * rstd * gdn.x * silu(bflo(z.x)), o1 * rstd * gdn.y * silu(bfhi(z.x)));
      o.y = pack2(o2 * rstd * gdn.z * silu(bflo(z.y)), o3 * rstd * gdn.w * silu(bfhi(z.y)));
      *(u32x2*)(pr + C_YDN + c0) = o;
    }
    {
      const u32x2 a = *(const u32x2*)(SC + 2 * st + so), bq = *(const u32x2*)(SC + 3 * st + so);
      const float o0 = bflo(a.x) + bflo(bq.x), o1 = bfhi(a.x) + bfhi(bq.x), o2 = bflo(a.y) + bflo(bq.y), o3 = bfhi(a.y) + bfhi(bq.y);
      const float ss = sum16(o0 * o0 + o1 * o1 + o2 * o2 + o3 * o3);
      const float rstd = rsqrtf(ss * (1.f / 64.f) + 1e-6f);
      const u32x2 z = *(const u32x2*)(pr + C_HGG + c0);
      u32x2 o;
      o.x = pack2(o0 * rstd * ghg.x * sigm(bflo(z.x)), o1 * rstd * ghg.y * sigm(bfhi(z.x)));
      o.y = pack2(o2 * rstd * ghg.z * sigm(bflo(z.y)), o3 * rstd * ghg.w * sigm(bfhi(z.y)));
      *(u32x2*)(pr + C_YHG + c0) = o;
    }
    {
      const u32x2 a = *(const u32x2*)(SC + 4 * st + so), bq = *(const u32x2*)(SC + 5 * st + so);
      const u32x2 u = *(const u32x2*)(pr + C_S5U + c0);
      float y[4];
      y[0] = bflo(a.x) + bflo(bq.x) + dsk.x * bflo(u.x);
      y[1] = bfhi(a.x) + bfhi(bq.x) + dsk.y * bfhi(u.x);
      y[2] = bflo(a.y) + bflo(bq.y) + dsk.z * bflo(u.y);
      y[3] = bfhi(a.y) + bfhi(bq.y) + dsk.w * bfhi(u.y);
#pragma unroll
      for (int e = 0; e < 4; ++e) {
        const float x = y[e];
        const float uu = 0.7978845608028654f * (x + 0.044715f * x * x * x);
        const float th = 1.f - 2.f / (1.f + __expf(2.f * uu));
        y[e] = 0.5f * x * (1.f + th);
      }
      u32x2 o; o.x = pack2(y[0], y[1]); o.y = pack2(y[2], y[3]);
      *(u32x2*)(pr + C_S5G + c0) = o;
    }
  }
}


#define XB_XCNT(j) (256 + 64 * (j))
#define XB_XSUB(j) (1280 + 64 * (j))
#define XB_XGEN(j) (2304 + 64 * (j))
#define XB_TOP 3328
#define XB_TOPGEN 3392
#define TICKET_BASE 3600
__device__ __forceinline__ unsigned xb_ld(unsigned* q) { return __hip_atomic_load(q, __ATOMIC_RELAXED, __HIP_MEMORY_SCOPE_AGENT); }
__device__ __forceinline__ unsigned xb_add(unsigned* q, unsigned v) { return __hip_atomic_fetch_add(q, v, __ATOMIC_RELAXED, __HIP_MEMORY_SCOPE_AGENT); }
__device__ __forceinline__ void grid_bar(unsigned* bar, unsigned k, unsigned x, unsigned nloc, unsigned nx) {
  asm volatile("s_waitcnt vmcnt(0)" ::: "memory");
  __syncthreads();
  if (threadIdx.x == 0) {
    __builtin_amdgcn_s_waitcnt(0);
    const unsigned old = xb_add(&bar[XB_XSUB(x)], 1u);
    if (old + 1u == k * nloc) {
      __builtin_amdgcn_fence(__ATOMIC_RELEASE, "agent");
      asm volatile("s_waitcnt vmcnt(0)" ::: "memory");
      const unsigned og = xb_add(&bar[XB_TOP], 1u);
      if (og + 1u == k * nx) xb_add(&bar[XB_TOPGEN], 1u);
      else while (xb_ld(&bar[XB_TOPGEN]) < k) __builtin_amdgcn_s_sleep(1);
      __builtin_amdgcn_fence(__ATOMIC_ACQUIRE, "agent");
      xb_add(&bar[XB_XGEN(x)], 1u);
      asm volatile("s_waitcnt vmcnt(0)" ::: "memory");
    } else {
      while (xb_ld(&bar[XB_XGEN(x)]) < k) __builtin_amdgcn_s_sleep(1);
      __builtin_amdgcn_fence(__ATOMIC_ACQUIRE, "agent");
      asm volatile("s_waitcnt vmcnt(0)" ::: "memory");
    }
  }
  __syncthreads();
}
__global__ void __launch_bounds__(256, 2) fwd_megakernel(Params p) {
  __shared__ __attribute__((aligned(16))) char smem[65536];
  cg::grid_group grid = cg::this_grid();
  unsigned* barc = (unsigned*)(p.ws + OFF_CTR);
  const unsigned xcc = (unsigned)__builtin_amdgcn_s_getreg((3 << 11) | 20) & 0xFu;
  if (threadIdx.x == 0) (void)xb_add(&barc[XB_XCNT(xcc)], 1u);
  unsigned bar_n = 0, nloc = 1, nx = 1;
  for (int rpt = 0; rpt < ((PROBE_MASK & 8) ? 2 : 1); ++rpt) phase_ada(p, smem);
#pragma unroll 1
  for (int step = 0; step < 28; ++step) {
    const int l = step / 14, k = step - l * 14;
    const bf16_t* Wb = WS_BF(p, OFF_W);
    const int mr2 = (l == 1) ? NLAT : NTOK;
    if (k == 0) {
      for (int rpt = 0; rpt < ((PROBE_MASK & 8) ? 2 : 1); ++rpt) phase_cvt(p, l, smem);
      if (l == 0) {
        grid.sync();
        unsigned cnt = 0;
        for (unsigned j = 0; j < 16; ++j) { const unsigned c = xb_ld(&barc[XB_XCNT(j)]); cnt += (c > 0u) ? 1u : 0u; if (j == xcc) nloc = c; }
        nx = cnt;
      }
    }
    if (k == 0 || k == 3 || k == 11) {
      const int which = (k == 0) ? 0 : (k == 3) ? 1 : 2;
      for (int rpt = 0; rpt < ((PROBE_MASK & 4) ? 2 : 1); ++rpt) phase_norm(p, l, which, k == 11 ? mr2 : NTOK);
    } else if (k == 1 || k == 12) {
      phase_ffn_up(p, k == 1 ? 0 : 1, k == 1 ? NTOK : mr2, smem, barc + TICKET_BASE + step * 8);
    } else if (k == 2 || k == 10 || k == 13) {
      const bf16_t* A = (k == 10) ? WS_BF(p, OFF_SC) : WS_BF(p, OFF_P);
      const int lda = (k == 10) ? DM : DFF;
      const bf16_t* Wt = (k == 10) ? Wb + W_OT : (k == 2) ? Wb + W_DN : Wb + W_DN + (size_t)1024 * 2816;
      const int gate_k = (k == 2) ? 2 : (k == 10) ? 5 : 8;
      const float scale = (k == 10) ? 1.0f : 0.5f;
      phase_resid_gemm(p, A, lda, Wt, lda, l, gate_k, scale, (l == 0 && k == 2), k == 2 ? NTOK : mr2, smem, barc + TICKET_BASE + step * 8);
    } else if (k == 4) {
      phase_win(p, smem, barc + TICKET_BASE + step * 8);
    } else if (k == 5) {
      phase_attn_prep(p, l);
    } else if (k == 6) {
      phase_mixers(p, l, smem, false);
      if (PROBE_MASK & 2) { grid_bar(barc, ++bar_n, xcc, nloc, nx); phase_mixers(p, l, smem, true); }
    } else if (k == 7) {
      for (int rpt = 0; rpt < ((PROBE_MASK & 4) ? 2 : 1); ++rpt) phase_postmix(p, l, mr2);
    } else if (k == 8) {
      for (int rpt = 0; rpt < ((PROBE_MASK & 1) ? 2 : 1); ++rpt) phase_glu(p, mr2, smem);
    } else if (k == 9) {
      for (int rpt = 0; rpt < ((PROBE_MASK & 1) ? 2 : 1); ++rpt) phase_merge(p, mr2, smem);
    }
    grid_bar(barc, ++bar_n, xcc, nloc, nx);
    if (PROBE_MASK & 16) grid_bar(barc, ++bar_n, xcc, nloc, nx);
  }
  phase_final_norm(p);
}

static void build_jobs(Params& p, int l) {
  bf16_t* W = (bf16_t*)(p.ws + OFF_W);
  CvtJob* J = p.jobs + l * 15;
  int n = 0, tiles = 0;
  auto add = [&](const float* src, bf16_t* dst, int K, int N, int nsrc, int ld_src, int ld_dst, int mode) {
    CvtJob j;
    memset(&j, 0, sizeof(j));
    j.src = src; j.dst = dst; j.K = K; j.N = N; j.nsrc = nsrc; j.ld_src = ld_src; j.ld_dst = ld_dst; j.mode = mode;
    j.ntk = K / 64; j.tile0 = tiles;
    tiles += (K / 64) * ((N + 63) / 64);
    J[n++] = j;
  };
  const float* w1 = p.in[7]; const float* w3 = p.in[8]; const float* w2 = p.in[9];
  for (int half = 0; half < 2; ++half) {
    add(w1 + (size_t)(l * 2 + half) * 1024 * 2816, W + W_UP + (size_t)half * 5632 * 1024, 1024, 2816, 2816, 2816, 1024, 1);
    add(w3 + (size_t)(l * 2 + half) * 1024 * 2816, W + W_UP + (size_t)half * 5632 * 1024, 1024, 2816, 2816, 2816, 1024, 2);
    add(w2 + (size_t)(l * 2 + half) * 2816 * 1024, W + W_DN + (size_t)half * 1024 * 2816, 2816, 1024, 1024, 1024, 2816, 0);
  }
  const float* win = p.in[10] + (size_t)l * 1024 * 7184;
  add(win, W + W_IN, 1024, 3200, 3088, 7184, 1024, 0);
  add(win + 3088, W + W_GT, 1024, 4096, 4096, 7184, 1024, 0);
  for (int i = 0; i < 4; ++i) add(p.in[28] + (size_t)(l * 4 + i) * 256 * 1024, W + W_BT + (size_t)i * 1024 * 256, 256, 1024, 1024, 1024, 256, 0);
  add(p.in[29] + (size_t)l * 1024 * 1024, W + W_OT, 1024, 1024, 1024, 1024, 1024, 0);
  add(p.in[23] + (size_t)l * 256 * 512, W + W_GLU, 256, 256, 256, 512, 256, 1);
  add(p.in[23] + (size_t)l * 256 * 512 + 256, W + W_GLU, 256, 256, 256, 512, 256, 2);
  p.job_tiles[l] = tiles;
}

extern "C" void kernel_launch(void* const* d_in, const int* in_sizes, int n_in, void* d_out, int out_size, void* d_ws, size_t ws_size,
                              hipStream_t stream) {
  static int grid_blocks = 0;
  if (!grid_blocks) {
    if (n_in != 31 || ws_size < WS_END) { fprintf(stderr, "kernel_launch: unexpected n_in %d / ws_size %zu (need %zu)\n", n_in, ws_size, (size_t)WS_END); grid_blocks = -1; return; }
    int dev = 0, cus = 0, per_cu = 0;
    hipGetDevice(&dev);
    hipDeviceGetAttribute(&cus, hipDeviceAttributeMultiprocessorCount, dev);
    hipOccupancyMaxActiveBlocksPerMultiprocessor(&per_cu, fwd_megakernel, 256, 0);
    if (per_cu < 1) per_cu = 1;
    if (per_cu > 2) per_cu = 2;
    grid_blocks = cus * per_cu;
    fprintf(stderr, "kernel_launch: grid %d (%d CUs x %d)\n", grid_blocks, cus, per_cu);
  }
  if (grid_blocks < 0) return;
  Params p;
  memset(&p, 0, sizeof(p));
  for (int i = 0; i < 31; ++i) p.in[i] = (const float*)d_in[i];
  p.out = (float*)d_out;
  p.ws = (char*)d_ws;
  build_jobs(p, 0);
  build_jobs(p, 1);
  if (hipMemsetAsync((char*)d_ws + OFF_CTR, 0, CTL_BYTES, stream) != hipSuccess) { fprintf(stderr, "kernel_launch: memset failed\n"); return; }
  void* args[] = {&p};
  hipError_t e = hipLaunchCooperativeKernel((void*)fwd_megakernel, dim3(grid_blocks), dim3(256), args, 0, stream);
  if (e != hipSuccess) fprintf(stderr, "cooperative launch failed: %s (grid %d)\n", hipGetErrorString(e), grid_blocks);
}
```

```cpp
#include <hip/hip_runtime.h>
#include <hip/hip_cooperative_groups.h>
#include <cstdio>
#include <cstring>
namespace cg = cooperative_groups;
#ifndef PROBE_MASK
#define PROBE_MASK 0
#endif

typedef unsigned short bf16_t;
using bf16x8 = __attribute__((ext_vector_type(8))) short;
using f32x4  = __attribute__((ext_vector_type(4))) float;
using u32x4  = __attribute__((ext_vector_type(4))) unsigned;
using u32x2  = __attribute__((ext_vector_type(2))) unsigned;

constexpr int DM = 1024, NBATCH = 16, SEQL = 2048, CTXL = 256, DFF = 2816;
constexpr int NLAT = NBATCH * SEQL;
constexpr int NCTXR = NBATCH * CTXL;
constexpr int NTOK = NLAT + NCTXR;
constexpr int PC = 3088;
constexpr int TJ = 2304;
constexpr int C_DNQKV = 0, C_DNZ = 768, C_DNA = 1024, C_DNB = 1032, C_S5U = 1040, C_HGQ = 1296, C_HGF = 1552,
              C_HGV = 2064, C_HGG = 2320, C_ATQ = 2576, C_ATK = 2832, C_ATV = 2960;
constexpr int C_YDN = 0, C_S5G = 256, C_YS5 = 512, C_YHG = 1296, C_YAT = 2832;

constexpr size_t W_UP = 0;
constexpr size_t W_DN = W_UP + 2ull * 5632 * 1024;
constexpr size_t W_IN = W_DN + 2ull * 1024 * 2816;
constexpr size_t W_GT = W_IN + 3200ull * 1024;
constexpr size_t W_BT = W_GT + 4096ull * 1024;
constexpr size_t W_OT = W_BT + 4ull * 1024 * 256;
constexpr size_t W_GLU = W_OT + 1024ull * 1024;
constexpr size_t W_ELEMS = W_GLU + 512ull * 256;
constexpr size_t OFF_W = 0;
constexpr size_t OFF_XC = OFF_W + W_ELEMS * 2;
constexpr size_t OFF_H = OFF_XC + (size_t)NCTXR * DM * 4;
constexpr size_t OFF_P = OFF_H + (size_t)NTOK * DM * 2;
constexpr size_t OFF_SC = OFF_P + (size_t)NTOK * PC * 2;
constexpr size_t OFF_KP = OFF_SC + 6ull * NTOK * 256 * 2;
constexpr size_t OFF_VT = OFF_KP + 16ull * 2 * TJ * 64 * 2;
constexpr size_t OFF_MOD = OFF_VT + 16ull * 2 * TJ * 64 * 2;
constexpr size_t OFF_CTR = OFF_MOD + 2ull * 17 * 9 * 1024 * 4;
constexpr size_t CTL_BYTES = 16384;
constexpr size_t WS_END = OFF_CTR + CTL_BYTES;
static_assert(WS_END <= 512ull * 1024 * 1024, "workspace too large");
static_assert((OFF_XC % 256) == 0 && (OFF_H % 256) == 0 && (OFF_P % 256) == 0 && (OFF_SC % 256) == 0 && (OFF_KP % 256) == 0 && (OFF_MOD % 256) == 0, "align");

struct CvtJob { const float* src; bf16_t* dst; int K, N, nsrc, ld_src, ld_dst, mode, ntk, tile0; };
struct Params {
  const float* in[31];
  float* out;
  char* ws;
  CvtJob jobs[30];
  int job_tiles[2];
  int pad[2];
};

__device__ __forceinline__ float bf2f(bf16_t b) { return __uint_as_float(((unsigned)b) << 16); }
__device__ __forceinline__ float bflo(unsigned u) { return __uint_as_float(u << 16); }
__device__ __forceinline__ float bfhi(unsigned u) { return __uint_as_float(u & 0xffff0000u); }
typedef __bf16 hwbf2_t __attribute__((ext_vector_type(2)));
typedef float hwf2_t __attribute__((ext_vector_type(2)));
__device__ __forceinline__ unsigned pack2(float a, float b) {
  hwf2_t v; v.x = a; v.y = b;
  const hwbf2_t r = __builtin_convertvector(v, hwbf2_t);
  return __builtin_bit_cast(unsigned, r);
}
__device__ __forceinline__ bf16_t f2bf(float f) { return (bf16_t)(pack2(f, 0.f) & 0xffffu); }
__device__ __forceinline__ float sigm(float x) { return __builtin_amdgcn_rcpf(1.f + __expf(-x)); }
__device__ __forceinline__ float silu(float x) { return x * sigm(x); }
__device__ __forceinline__ float wave_sum(float v) {
#pragma unroll
  for (int o = 32; o >= 1; o >>= 1) v += __shfl_xor(v, o);
  return v;
}
__device__ __forceinline__ float quad_sum(float x) {
  x += __int_as_float(__builtin_amdgcn_update_dpp(0, __float_as_int(x), 0xB1, 0xF, 0xF, true));
  x += __int_as_float(__builtin_amdgcn_update_dpp(0, __float_as_int(x), 0x4E, 0xF, 0xF, true));
  return x;
}
__device__ __forceinline__ int otid() { int t = threadIdx.x; asm volatile("" : "+v"(t)); return t; }
__device__ __forceinline__ int frag_off(int fr, int fq) { return (fr >> 3) * 1024 + (fr & 7) * 128 + ((fq ^ ((fr >> 1) & 7)) << 4); }
__device__ __forceinline__ int lds_inner(int fr, int cbyte) { int ob = fr * 64 + cbyte; return ob ^ (((ob >> 9) & 1) << 5); }
__device__ __forceinline__ int lds_byte(int r, int c) { return ((r >> 4) * 2 + (c >> 5)) * 1024 + lds_inner(r & 15, (c & 31) * 2); }
__device__ __forceinline__ int seq_row(int b, int dir, int s) {
  if (s < CTXL) { int pos = dir ? (CTXL - 1 - s) : s; return NLAT + b * CTXL + pos; }
  int sl = s - CTXL; int pos = dir ? (SEQL - 1 - sl) : sl; return b * SEQL + pos;
}
__device__ __forceinline__ int mod_idx(int row) { return row < NLAT ? (row >> 11) : 16; }

template <int NT, bool LEAN = false>
__device__ __forceinline__ void gemm_main(const bf16_t* __restrict__ A, int lda, const bf16_t* __restrict__ Bt, int ldb, int K,
                                          f32x4 (&acc)[4][NT], char* smem, int bs1 = 32, int bs2 = 64) {
  const int tid = otid(), lane = tid & 63, wid = tid >> 6, wr = wid >> 1, wc = wid & 1, fr = lane & 15, fq = lane >> 4;
  const int o0 = tid * 16;
  const int lrow = (o0 >> 10) * 8 + ((o0 >> 7) & 7), lcol = ((((o0 >> 4) & 7) ^ ((lrow >> 1) & 7))) * 8;
  const bf16_t* ag = A + (size_t)lrow * lda + lcol;
  const bf16_t* bg = Bt + (size_t)lrow * ldb + lcol;
  const char* A8 = (const char*)A;
  const char* B8 = (const char*)Bt;
  unsigned aoff[4], boff[NT];
#pragma unroll
  for (int i = 0; i < 4; ++i) aoff[i] = (unsigned)(((lrow + 32 * i) * lda + lcol) * 2);
#pragma unroll
  for (int i = 0; i < NT; ++i) boff[i] = (unsigned)(((lrow + (i & 1) * bs1 + (i >> 1) * bs2) * ldb + lcol) * 2);
  const int wbase = __builtin_amdgcn_readfirstlane(wid) * 1024;
  const int inner = frag_off(fr, fq);
  const int abase = wr * 8192 + inner;
  const int bbase = 16384 + wc * (NT * 2048) + inner;
  const int nk = K >> 6;
#pragma unroll
  for (int i = 0; i < 4; ++i) __builtin_amdgcn_global_load_lds((const unsigned*)(ag + (size_t)(32 * i) * lda), (unsigned*)(smem + i * 4096 + o0), 16, 0, 0);
#pragma unroll
  for (int i = 0; i < NT; ++i) __builtin_amdgcn_global_load_lds((const unsigned*)(bg + (size_t)((i & 1) * bs1 + (i >> 1) * bs2) * ldb), (unsigned*)(smem + 16384 + i * 4096 + o0), 16, 0, 0);
  asm volatile("s_waitcnt vmcnt(0)" ::: "memory");
  __syncthreads();
  for (int kt = 0; kt < nk; ++kt) {
    const int cur = (kt & 1) * 32768, nxt = 32768 - cur;
    if (kt + 1 < nk) {
#pragma unroll
      for (int i = 0; i < 4; ++i)
        __builtin_amdgcn_global_load_lds((const unsigned*)(A8 + (size_t)(kt + 1) * 128 + aoff[i]), (unsigned*)(smem + nxt + i * 4096 + wbase), 16, 0, 0);
#pragma unroll
      for (int i = 0; i < NT; ++i)
        __builtin_amdgcn_global_load_lds((const unsigned*)(B8 + (size_t)(kt + 1) * 128 + boff[i]), (unsigned*)(smem + nxt + 16384 + i * 4096 + wbase), 16, 0, 0);
    }
    __builtin_amdgcn_sched_barrier(0);
    if (LEAN) {
#pragma unroll
      for (int ks = 0; ks < 2; ++ks) {
        bf16x8 af[4], bfr[NT];
#pragma unroll
        for (int m = 0; m < 4; ++m) af[m] = *(const bf16x8*)(smem + cur + ((abase + m * 2048) ^ (ks * 64)));
#pragma unroll
        for (int n = 0; n < NT; ++n) bfr[n] = *(const bf16x8*)(smem + cur + ((bbase + n * 2048) ^ (ks * 64)));
        __builtin_amdgcn_s_setprio(1);
#pragma unroll
        for (int m = 0; m < 4; ++m)
#pragma unroll
          for (int n = 0; n < NT; ++n) acc[m][n] = __builtin_amdgcn_mfma_f32_16x16x32_bf16(bfr[n], af[m], acc[m][n], 0, 0, 0);
        __builtin_amdgcn_s_setprio(0);
      }
    } else {
    bf16x8 af0[4], bf0[NT], af1[4], bf1[NT];
#pragma unroll
    for (int m = 0; m < 4; ++m) af0[m] = *(const bf16x8*)(smem + cur + (abase + m * 2048));
#pragma unroll
    for (int n = 0; n < NT; ++n) bf0[n] = *(const bf16x8*)(smem + cur + (bbase + n * 2048));
#pragma unroll
    for (int m = 0; m < 4; ++m) af1[m] = *(const bf16x8*)(smem + cur + ((abase + m * 2048) ^ 64));
#pragma unroll
    for (int n = 0; n < NT; ++n) bf1[n] = *(const bf16x8*)(smem + cur + ((bbase + n * 2048) ^ 64));
    __builtin_amdgcn_sched_barrier(0);
    __builtin_amdgcn_s_setprio(1);
#pragma unroll
    for (int m = 0; m < 4; ++m)
#pragma unroll
      for (int n = 0; n < NT; ++n) acc[m][n] = __builtin_amdgcn_mfma_f32_16x16x32_bf16(bf0[n], af0[m], acc[m][n], 0, 0, 0);
#pragma unroll
    for (int m = 0; m < 4; ++m)
#pragma unroll
      for (int n = 0; n < NT; ++n) acc[m][n] = __builtin_amdgcn_mfma_f32_16x16x32_bf16(bf1[n], af1[m], acc[m][n], 0, 0, 0);
    __builtin_amdgcn_s_setprio(0);
    }
    __builtin_amdgcn_sched_barrier(0);
    asm volatile("s_waitcnt vmcnt(0)" ::: "memory");
    __syncthreads();
  }
}

template <int NT>
__device__ __forceinline__ void zero_acc(f32x4 (&acc)[4][NT]) {
#pragma unroll
  for (int m = 0; m < 4; ++m)
#pragma unroll
    for (int n = 0; n < NT; ++n) acc[m][n] = f32x4{0.f, 0.f, 0.f, 0.f};
}

#define WS_BF(p, off) ((bf16_t*)((p).ws + (off)))
#define WS_F32(p, off) ((float*)((p).ws + (off)))
__device__ __forceinline__ const float* mods_ptr(const Params& p, int l, int bi, int k) {
  return WS_F32(p, OFF_MOD) + ((size_t)((l * 17 + bi) * 9 + k)) * 1024;
}

__device__ __forceinline__ void cvt_tile(const CvtJob& j, int t, char* smem) {
  float* ts = (float*)smem;
  const int tid = otid();
  const int tk = t % j.ntk, tn = t / j.ntk, k0 = tk * 64, n0 = tn * 64;
  {
    const int n4 = (tid & 15) * 4, n = n0 + n4, kr = tid >> 4;
    float4 v[4];
#pragma unroll
    for (int i = 0; i < 4; ++i) {
      const int k = kr + 16 * i;
      v[i] = (n < j.nsrc) ? *(const float4*)(j.src + (size_t)(k0 + k) * j.ld_src + n) : float4{0.f, 0.f, 0.f, 0.f};
    }
#pragma unroll
    for (int i = 0; i < 4; ++i) {
      const int k = kr + 16 * i;
      ts[k * 65 + n4 + 0] = v[i].x; ts[k * 65 + n4 + 1] = v[i].y; ts[k * 65 + n4 + 2] = v[i].z; ts[k * 65 + n4 + 3] = v[i].w;
    }
  }
  __syncthreads();
#pragma unroll
  for (int i = 0; i < 2; ++i) {
    const int c = tid + 256 * i, nl = c >> 3, kc = (c & 7) * 8, n = n0 + nl;
    if (n < j.N) {
      const int row = (j.mode == 0) ? n : ((n >> 4) * 32 + (n & 15) + (j.mode == 2 ? 16 : 0));
      u32x4 o;
      o.x = pack2(ts[(kc + 0) * 65 + nl], ts[(kc + 1) * 65 + nl]);
      o.y = pack2(ts[(kc + 2) * 65 + nl], ts[(kc + 3) * 65 + nl]);
      o.z = pack2(ts[(kc + 4) * 65 + nl], ts[(kc + 5) * 65 + nl]);
      o.w = pack2(ts[(kc + 6) * 65 + nl], ts[(kc + 7) * 65 + nl]);
      *(u32x4*)(j.dst + (size_t)row * j.ld_dst + k0 + kc) = o;
    }
  }
  __syncthreads();
}
__device__ __forceinline__ void phase_cvt(const Params& p, int l, char* smem) {
  const int total = p.job_tiles[l];
  for (int t = blockIdx.x; t < total; t += gridDim.x) {
    int ji = 0;
#pragma unroll 1
    for (int q = 1; q < 15; ++q) if (t >= p.jobs[l * 15 + q].tile0) ji = q;
    const CvtJob& j = p.jobs[l * 15 + ji];
    cvt_tile(j, t - j.tile0, smem);
  }
}

__device__ __forceinline__ void phase_ada(const Params& p, char* smem) {
  float* sc = (float*)smem;
  const int tid = otid(), c = tid & 63, kg = tid >> 6;
  for (int task = blockIdx.x; task < 2 * 144; task += gridDim.x) {
    const int l = task / 144, n0 = (task % 144) * 64;
    const float* W = p.in[4] + (size_t)l * 1024 * 9216;
    float acc[17];
#pragma unroll
    for (int r = 0; r < 17; ++r) acc[r] = 0.f;
    for (int kh = 0; kh < 2; ++kh) {
      __syncthreads();
      for (int i = tid; i < 17 * 512; i += 256) {
        const int r = i >> 9, k = (i & 511) + kh * 512;
        const float v = (r < 16) ? p.in[1][r * 1024 + k] : p.in[3][k];
        sc[i] = silu(v);
      }
      __syncthreads();
#pragma unroll 4
      for (int kk = 0; kk < 128; kk += 4) {
        const int kl = kg * 128 + kk;
        const float* wp = W + (size_t)(kh * 512 + kl) * 9216 + n0 + c;
        const float w0 = wp[0], w1 = wp[9216], w2 = wp[2 * 9216], w3 = wp[3 * 9216];
#pragma unroll
        for (int r = 0; r < 17; ++r) {
          const float4 s4 = *(const float4*)(sc + r * 512 + kl);
          acc[r] += s4.x * w0 + s4.y * w1 + s4.z * w2 + s4.w * w3;
        }
      }
    }
    __syncthreads();
#pragma unroll
    for (int r = 0; r < 17; ++r) sc[(kg * 17 + r) * 64 + c] = acc[r];
    __syncthreads();
    for (int i = tid; i < 17 * 64; i += 256) {
      const int r = i >> 6, cc = i & 63;
      float s = 0.f;
#pragma unroll
      for (int g = 0; g < 4; ++g) s += sc[(g * 17 + r) * 64 + cc];
      const int n = n0 + cc;
      WS_F32(p, OFF_MOD)[(size_t)(l * 17 + r) * 9216 + n] = s + p.in[5][l * 9216 + n];
    }
    __syncthreads();
  }
}

__device__ __forceinline__ const float* xrow_ptr(const Params& p, bool from_input, int r) {
  if (from_input) return r < NLAT ? p.in[0] + (size_t)r * DM : p.in[2] + (size_t)(r - NLAT) * DM;
  return r < NLAT ? p.out + (size_t)r * DM : WS_F32(p, OFF_XC) + (size_t)(r - NLAT) * DM;
}
__device__ __forceinline__ float* xrow_out(const Params& p, int r) {
  return r < NLAT ? p.out + (size_t)r * DM : WS_F32(p, OFF_XC) + (size_t)(r - NLAT) * DM;
}
__device__ __forceinline__ void phase_norm(const Params& p, int l, int which, int nrows) {
  const float* g = p.in[6] + (l * 3 + which) * 1024;
  const int tidq = otid(); const int lane = tidq & 63;
  bf16_t* H = WS_BF(p, OFF_H);
  const bool from_input = (l == 0 && which == 0);
  const int nw = gridDim.x * 4, gw = blockIdx.x * 4 + (tidq >> 6);
  const int rpw = (nrows + nw - 1) / nw;
  const int r0 = gw * rpw, r1 = (r0 + rpw < nrows) ? r0 + rpw : nrows;
  float4 g4[4], s4[4], c4[4];
#pragma unroll
  for (int i = 0; i < 4; ++i) g4[i] = *(const float4*)(g + i * 256 + lane * 4);
  int cur_bi = -1;
  for (int r = r0; r < r1; ++r) {
    const float* xr = xrow_ptr(p, from_input, r);
    const int bi = mod_idx(r);
    if (bi != cur_bi) {
      const float* sh = mods_ptr(p, l, bi, which * 3);
#pragma unroll
      for (int i = 0; i < 4; ++i) { s4[i] = *(const float4*)(sh + i * 256 + lane * 4); c4[i] = *(const float4*)(sh + 1024 + i * 256 + lane * 4); }
      cur_bi = bi;
    }
    float4 v[4];
    float ss = 0.f;
#pragma unroll
    for (int i = 0; i < 4; ++i) {
      v[i] = *(const float4*)(xr + i * 256 + lane * 4);
      ss += v[i].x * v[i].x + v[i].y * v[i].y + v[i].z * v[i].z + v[i].w * v[i].w;
    }
    ss = wave_sum(ss);
    const float rstd = rsqrtf(ss * (1.f / 1024.f) + 1e-6f);
#pragma unroll
    for (int i = 0; i < 4; ++i) {
      const int c = i * 256 + lane * 4;
      const float y0 = (v[i].x * rstd * g4[i].x) * (1.f + c4[i].x) + s4[i].x;
      const float y1 = (v[i].y * rstd * g4[i].y) * (1.f + c4[i].y) + s4[i].y;
      const float y2 = (v[i].z * rstd * g4[i].z) * (1.f + c4[i].z) + s4[i].z;
      const float y3 = (v[i].w * rstd * g4[i].w) * (1.f + c4[i].w) + s4[i].w;
      u32x2 o; o.x = pack2(y0, y1); o.y = pack2(y2, y3);
      *(u32x2*)(H + (size_t)r * DM + c) = o;
    }
  }
}
__device__ __forceinline__ void phase_final_norm(const Params& p) {
  const float* g = p.in[30];
  const int tidq = otid(); const int lane = tidq & 63;
  float4 g4[4];
#pragma unroll
  for (int i = 0; i < 4; ++i) g4[i] = *(const float4*)(g + i * 256 + lane * 4);
  for (int r = blockIdx.x * 4 + (tidq >> 6); r < NLAT; r += gridDim.x * 4) {
    float* xr = p.out + (size_t)r * DM;
    float4 v[4];
    float ss = 0.f;
#pragma unroll
    for (int i = 0; i < 4; ++i) {
      v[i] = *(const float4*)(xr + i * 256 + lane * 4);
      ss += v[i].x * v[i].x + v[i].y * v[i].y + v[i].z * v[i].z + v[i].w * v[i].w;
    }
    ss = wave_sum(ss);
    const float rstd = rsqrtf(ss * (1.f / 1024.f) + 1e-6f);
#pragma unroll
    for (int i = 0; i < 4; ++i) {
      float4 o; o.x = v[i].x * rstd * g4[i].x; o.y = v[i].y * rstd * g4[i].y; o.z = v[i].z * rstd * g4[i].z; o.w = v[i].w * rstd * g4[i].w;
      *(float4*)(xr + i * 256 + lane * 4) = o;
    }
  }
}


struct TileIter {
  int e, ecount, nb, x, SH, SW, nsc;
  unsigned* cnt;
  unsigned tick;
  __device__ __forceinline__ TileIter(int ntm, int ntn, int sh, int sw, unsigned* cnt_ = nullptr) {
    x = blockIdx.x & 7; nb = gridDim.x >> 3; e = blockIdx.x >> 3; SH = sh; SW = sw; nsc = ntn / sw;
    const int NS = (ntm / sh) * nsc;
    ecount = ((NS - x + 7) >> 3) * sh * sw;
    cnt = cnt_ ? cnt_ + x : nullptr;
    tick = 0;
  }
  __device__ __forceinline__ bool valid() const { return e < ecount; }
  __device__ __forceinline__ void prefetch() {
    if (cnt && threadIdx.x == 0) tick = __hip_atomic_fetch_add(cnt, 1u, __ATOMIC_RELAXED, __HIP_MEMORY_SCOPE_AGENT);
  }
  __device__ __forceinline__ void next(char* smem) {
    if (!cnt) { e += nb; return; }
    if (threadIdx.x == 0) *(volatile int*)smem = (int)tick + nb;
    __syncthreads();
    e = *(volatile int*)smem;
    __syncthreads();
  }
  __device__ __forceinline__ void next() { e += nb; }
  __device__ __forceinline__ void get(int& tm, int& tn) const {
    const int per = SH * SW, si = e / per, r = e - si * per, s = x + 8 * si;
    const int sg = s / nsc, sc = s - sg * nsc;
    const int rr = r / SW;
    tm = sg * SH + rr; tn = sc * SW + (r - rr * SW);
  }
};
#define TILE_IDS const int tid = otid(), lane = tid & 63, wid = tid >> 6, wr = wid >> 1, wc = wid & 1, fr = lane & 15, fq = lane >> 4

__device__ __forceinline__ void phase_ffn_up(const Params& p, int half, int mrows, char* smem, unsigned* tk) {
  TILE_IDS; (void)tid;
  const bf16_t* H = WS_BF(p, OFF_H);
  const bf16_t* W = WS_BF(p, OFF_W) + W_UP + (size_t)half * 5632 * 1024;
  bf16_t* ACT = WS_BF(p, OFF_P);
  for (TileIter ti(mrows / 128, 44, 8, 11, tk); ti.valid();) {
    int tm, tn; ti.get(tm, tn);
    ti.prefetch();
    f32x4 acc[4][4];
    zero_acc<4>(acc);
    gemm_main<4>(H + (size_t)tm * 128 * DM, DM, W + (size_t)tn * 128 * DM, DM, DM, acc, smem);
    ti.next(smem);
    bf16_t* ob = ACT + (size_t)(tm * 128 + wr * 64 + fr) * DFF + tn * 64 + wc * 32 + fq * 4;
#pragma unroll
    for (int m = 0; m < 4; ++m) {
#pragma unroll
      for (int np = 0; np < 2; ++np) {
        float o[4];
#pragma unroll
        for (int j = 0; j < 4; ++j) o[j] = silu(acc[m][2 * np][j]) * acc[m][2 * np + 1][j];
        u32x2 pk; pk.x = pack2(o[0], o[1]); pk.y = pack2(o[2], o[3]);
        *(u32x2*)(ob + (m * 16) * DFF + np * 16) = pk;
      }
      __builtin_amdgcn_sched_barrier(0);
    }
  }
}

__device__ __forceinline__ void phase_resid_gemm(const Params& p, const bf16_t* A, int lda, const bf16_t* Wt, int K, int l, int gate_k, float scale,
                                 bool from_input, int mrows, char* smem, unsigned* tk) {
  TILE_IDS; (void)tid;
  for (TileIter ti(mrows / 128, 8, 4, 8, tk); ti.valid();) {
    int tm, tn; ti.get(tm, tn);
    ti.prefetch();
    f32x4 acc[4][4];
    zero_acc<4>(acc);
    gemm_main<4>(A + (size_t)tm * 128 * lda, lda, Wt + (size_t)tn * 128 * K, K, K, acc, smem);
    ti.next(smem);
    const int bi = mod_idx(tm * 128);
    const float* gate = mods_ptr(p, l, bi, gate_k);
    const int row0 = tm * 128 + wr * 64 + fr, col0 = tn * 128 + wc * 64 + fq * 4;
    const float* xi = xrow_ptr(p, from_input, row0) + col0;
    float* xo = xrow_out(p, row0) + col0;
    float4 gv[4];
#pragma unroll
    for (int n = 0; n < 4; ++n) {
      gv[n] = *(const float4*)(gate + col0 + n * 16);
      gv[n].x *= scale; gv[n].y *= scale; gv[n].z *= scale; gv[n].w *= scale;
    }
#pragma unroll
    for (int m = 0; m < 4; ++m) {
#pragma unroll
      for (int n = 0; n < 4; ++n) {
        const float4 xv = *(const float4*)(xi + (m * 16) * DM + n * 16);
        float4 ov;
        ov.x = xv.x + gv[n].x * acc[m][n][0];
        ov.y = xv.y + gv[n].y * acc[m][n][1];
        ov.z = xv.z + gv[n].z * acc[m][n][2];
        ov.w = xv.w + gv[n].w * acc[m][n][3];
        *(float4*)(xo + (m * 16) * DM + n * 16) = ov;
      }
      __builtin_amdgcn_sched_barrier(0);
    }
  }
}

__device__ __forceinline__ void phase_win(const Params& p, char* smem, unsigned* tk) {
  TILE_IDS; (void)tid;
  const bf16_t* H = WS_BF(p, OFF_H);
  const bf16_t* W = WS_BF(p, OFF_W) + W_IN;
  bf16_t* P = WS_BF(p, OFF_P);
  for (TileIter ti(NTOK / 128, 25, 8, 5, tk); ti.valid();) {
    int tm, tn; ti.get(tm, tn);
    ti.prefetch();
    f32x4 acc[4][4];
    zero_acc<4>(acc);
    gemm_main<4>(H + (size_t)tm * 128 * DM, DM, W + (size_t)tn * 128 * DM, DM, DM, acc, smem);
    ti.next(smem);
    const int col0 = tn * 128 + wc * 64 + fq * 4;
    bf16_t* ob = P + (size_t)(tm * 128 + wr * 64 + fr) * PC + col0;
#pragma unroll
    for (int m = 0; m < 4; ++m) {
#pragma unroll
      for (int n = 0; n < 4; ++n) {
        if (col0 + n * 16 < PC) {
          u32x2 pk; pk.x = pack2(acc[m][n][0], acc[m][n][1]); pk.y = pack2(acc[m][n][2], acc[m][n][3]);
          *(u32x2*)(ob + (m * 16) * PC + n * 16) = pk;
        }
      }
      __builtin_amdgcn_sched_barrier(0);
    }
  }
}

__device__ __forceinline__ void phase_glu(const Params& p, int mrows, char* smem) {
  TILE_IDS; (void)tid;
  bf16_t* P = WS_BF(p, OFF_P);
  const bf16_t* W = WS_BF(p, OFF_W) + W_GLU;
  for (TileIter ti(mrows / 128, 4, 4, 4); ti.valid(); ti.next()) {
    int tm, tn; ti.get(tm, tn);
    f32x4 acc[4][4];
    zero_acc<4>(acc);
    gemm_main<4>(P + (size_t)tm * 128 * PC + C_S5G, PC, W + (size_t)tn * 128 * 256, 256, 256, acc, smem);
    bf16_t* ob = P + (size_t)(tm * 128 + wr * 64 + fr) * PC + C_YS5 + tn * 64 + wc * 32 + fq * 4;
#pragma unroll
    for (int m = 0; m < 4; ++m) {
#pragma unroll
      for (int np = 0; np < 2; ++np) {
        float o[4];
#pragma unroll
        for (int j = 0; j < 4; ++j) o[j] = acc[m][2 * np][j] * sigm(acc[m][2 * np + 1][j]);
        u32x2 pk; pk.x = pack2(o[0], o[1]); pk.y = pack2(o[2], o[3]);
        *(u32x2*)(ob + (m * 16) * PC + np * 16) = pk;
      }
      __builtin_amdgcn_sched_barrier(0);
    }
  }
}

__device__ __forceinline__ void phase_merge(const Params& p, int mrows, char* smem) {
  TILE_IDS; (void)tid;
  const bf16_t* H = WS_BF(p, OFF_H);
  const bf16_t* P = WS_BF(p, OFF_P);
  const bf16_t* WG = WS_BF(p, OFF_W) + W_GT;
  const bf16_t* WB = WS_BF(p, OFF_W) + W_BT;
  bf16_t* ACC = WS_BF(p, OFF_SC);
  for (TileIter ti(mrows / 128, 16, 4, 8); ti.valid(); ti.next()) {
    int tm, tn; ti.get(tm, tn);
    f32x4 sum[4][2];
    zero_acc<2>(sum);
#pragma unroll 1
    for (int ip = 0; ip < 2; ++ip) {
      const int i0 = 2 * ip;
      f32x4 g[4][4];
      zero_acc<4>(g);
      gemm_main<4, true>(H + (size_t)tm * 128 * DM, DM, WG + ((size_t)i0 * 1024 + tn * 64) * DM, DM, DM, g, smem, 1024, 32);
      u32x2 gp[4][4];
#pragma unroll
      for (int m = 0; m < 4; ++m)
#pragma unroll
        for (int n = 0; n < 4; ++n) {
          gp[m][n].x = pack2(sigm(g[m][n][0]), sigm(g[m][n][1]));
          gp[m][n].y = pack2(sigm(g[m][n][2]), sigm(g[m][n][3]));
        }
      __builtin_amdgcn_sched_barrier(0);
#pragma unroll 1
      for (int q = 0; q < 2; ++q) {
        const int i = i0 + q;
        const int ycol = (i == 0) ? C_YDN : (i == 1) ? C_YS5 : (i == 2) ? C_YHG : C_YAT;
        f32x4 y[4][2];
        zero_acc<2>(y);
        __builtin_amdgcn_sched_barrier(0);
        gemm_main<2, true>(P + (size_t)tm * 128 * PC + ycol, PC, WB + ((size_t)i * 1024 + tn * 64) * 256, 256, 256, y, smem);
        __builtin_amdgcn_sched_barrier(0);
#pragma unroll
        for (int m = 0; m < 4; ++m) {
#pragma unroll
          for (int n = 0; n < 2; ++n)
#pragma unroll
            for (int j = 0; j < 4; ++j) {
              const unsigned wa_ = (j < 2) ? gp[m][n].x : gp[m][n].y;
              const unsigned wb_ = (j < 2) ? gp[m][2 + n].x : gp[m][2 + n].y;
              const unsigned w_ = q ? wb_ : wa_;
              const float gj = (j & 1) ? bfhi(w_) : bflo(w_);
              sum[m][n][j] += gj * y[m][n][j];
            }
          __builtin_amdgcn_sched_barrier(0);
        }
      }
    }
    bf16_t* ob = ACC + (size_t)(tm * 128 + wr * 64 + fr) * DM + tn * 64 + wc * 32 + fq * 4;
#pragma unroll
    for (int m = 0; m < 4; ++m) {
#pragma unroll
      for (int n = 0; n < 2; ++n) {
        u32x2 pk; pk.x = pack2(sum[m][n][0], sum[m][n][1]); pk.y = pack2(sum[m][n][2], sum[m][n][3]);
        *(u32x2*)(ob + (m * 16) * DM + n * 16) = pk;
      }
      __builtin_amdgcn_sched_barrier(0);
    }
  }
}

__device__ __forceinline__ void phase_attn_prep(const Params& p, int l) {
  bf16_t* P = WS_BF(p, OFF_P);
  bf16_t* KP = WS_BF(p, OFF_KP);
  bf16_t* VT = WS_BF(p, OFF_VT);
  const float* qg = p.in[26] + l * 64;
  const float* kg = p.in[27] + l * 64;
  const int total = NTOK * 16;
  const int tidq = otid();
#pragma unroll 1
  for (int idx = blockIdx.x * 256 + tidq; idx < total; idx += gridDim.x * 256) {
    const int hf = idx & 1, it = idx >> 1;
    const int vec = it / NTOK, tok = it - vec * NTOK;
    const bool lat = tok < NLAT;
    const int b = lat ? (tok >> 11) : ((tok - NLAT) >> 8);
    const int pos = lat ? (tok & 2047) : ((tok - NLAT) & 255);
    const int col = (vec < 4 ? C_ATQ + vec * 64 : (vec < 6 ? C_ATK + (vec - 4) * 64 : C_ATV + (vec - 6) * 64)) + hf * 32;
    bf16_t* src = P + (size_t)tok * PC + col;
    u32x4 raw[4];
#pragma unroll
    for (int i = 0; i < 4; ++i) raw[i] = *(const u32x4*)(src + i * 8);
    const int key = lat ? CTXL + pos : pos;
    if (vec < 6) {
      float x[32];
#pragma unroll
      for (int i = 0; i < 4; ++i) {
        x[i * 8 + 0] = bflo(raw[i].x); x[i * 8 + 1] = bfhi(raw[i].x);
        x[i * 8 + 2] = bflo(raw[i].y); x[i * 8 + 3] = bfhi(raw[i].y);
        x[i * 8 + 4] = bflo(raw[i].z); x[i * 8 + 5] = bfhi(raw[i].z);
        x[i * 8 + 6] = bflo(raw[i].w); x[i * 8 + 7] = bfhi(raw[i].w);
      }
      float ss = 0.f;
#pragma unroll
      for (int i = 0; i < 32; ++i) ss += x[i] * x[i];
      ss += __shfl_xor(ss, 1);
      const float rstd = rsqrtf(ss * (1.f / 64.f) + 1e-6f);
      const float* gg = (vec < 4 ? qg : kg) + hf * 32;
#pragma unroll
      for (int i = 0; i < 32; ++i) x[i] = x[i] * rstd * gg[i];
      if (lat) {
        const float ang = hf ? (float)(pos & 63) : (float)(pos >> 6);
#pragma unroll
        for (int i = 0; i < 16; ++i) {
          const float inv = exp2f(-(float)i * (13.287712379549449f / 16.f));
          float s1, c1;
          __sincosf(ang * inv, &s1, &c1);
          const float x1 = x[i], x2 = x[16 + i];
          x[i] = x1 * c1 - x2 * s1;
          x[16 + i] = x2 * c1 + x1 * s1;
        }
      }
      const float qs = (vec < 4) ? 0.125f * 1.4426950408889634f : 1.f;
      bf16_t* dst = (vec < 4) ? src : KP + ((size_t)(b * 2 + (vec - 4)) * TJ + key) * 64 + hf * 32;
#pragma unroll
      for (int i = 0; i < 4; ++i) {
        u32x4 o;
        o.x = pack2(x[i * 8 + 0] * qs, x[i * 8 + 1] * qs);
        o.y = pack2(x[i * 8 + 2] * qs, x[i * 8 + 3] * qs);
        o.z = pack2(x[i * 8 + 4] * qs, x[i * 8 + 5] * qs);
        o.w = pack2(x[i * 8 + 6] * qs, x[i * 8 + 7] * qs);
        *(u32x4*)(dst + i * 8) = o;
      }
    } else {
      const int w = key & 31, ww = w & 15;
      const int slot = (key & ~31) + (ww >> 2) * 8 + (ww & 3) + (w >= 16 ? 4 : 0);
      bf16_t* dst = VT + ((size_t)(b * 2 + (vec - 6)) * 64 + hf * 32) * TJ + slot;
#pragma unroll
      for (int i = 0; i < 4; ++i) {
        dst[(size_t)(i * 8 + 0) * TJ] = (bf16_t)(raw[i].x & 0xffff); dst[(size_t)(i * 8 + 1) * TJ] = (bf16_t)(raw[i].x >> 16);
        dst[(size_t)(i * 8 + 2) * TJ] = (bf16_t)(raw[i].y & 0xffff); dst[(size_t)(i * 8 + 3) * TJ] = (bf16_t)(raw[i].y >> 16);
        dst[(size_t)(i * 8 + 4) * TJ] = (bf16_t)(raw[i].z & 0xffff); dst[(size_t)(i * 8 + 5) * TJ] = (bf16_t)(raw[i].z >> 16);
        dst[(size_t)(i * 8 + 6) * TJ] = (bf16_t)(raw[i].w & 0xffff); dst[(size_t)(i * 8 + 7) * TJ] = (bf16_t)(raw[i].w >> 16);
      }
    }
  }
}

using f32x2 = __attribute__((ext_vector_type(2))) float;
__device__ __forceinline__ f32x2 mk2(float a, float b) { f32x2 r; r.x = a; r.y = b; return r; }

__device__ __forceinline__ void dn_task(const Params& p, int l, int task, char* smem) {
  const int tid = otid();
  const int dir = task & 1, hd = (task >> 1) & 3, vh = (task >> 3) & 1, b = task >> 4;
  float* qs = (float*)smem;
  float* ks = qs + 32 * 68;
  float* vs = ks + 32 * 68;
  float* al = vs + 32 * 64;
  float* dots = al + 64;
  float* wl = al + 128;
  bf16_t* rawb = (bf16_t*)(wl + 5 * 192);
  const bf16_t* P = WS_BF(p, OFF_P);
  const float* cw = p.in[11] + (size_t)l * 5 * 768;
  const float Aexp = __expf(p.in[12][l * 8 + dir * 4 + hd]);
  const float dtb = p.in[13][l * 8 + dir * 4 + hd];
  bf16_t* O = WS_BF(p, OFF_SC) + (size_t)dir * NTOK * 256;
  const int v = vh * 32 + (tid >> 3), kq = tid & 7;
  for (int i = tid; i < 5 * 192; i += 256) {
    const int j = i / 192, c = i - j * 192;
    wl[i] = cw[j * 768 + (c >> 6) * 256 + hd * 64 + (c & 63)];
  }
  float ra = 0.f, rb = 0.f;
  f32x2 S2[4];
#pragma unroll
  for (int i = 0; i < 4; ++i) S2[i] = mk2(0.f, 0.f);
#define OCT_SUM(x_)                                                                                   \
  {                                                                                                   \
    x_ += __int_as_float(__builtin_amdgcn_update_dpp(0, __float_as_int(x_), 0xB1, 0xF, 0xF, true));   \
    x_ += __int_as_float(__builtin_amdgcn_update_dpp(0, __float_as_int(x_), 0x4E, 0xF, 0xF, true));   \
    x_ += __int_as_float(__builtin_amdgcn_update_dpp(0, __float_as_int(x_), 0x141, 0xF, 0xF, true));  \
  }

#define DN_PREFETCH(n_)                                                                                        \
  {                                                                                                            \
    const bool isctx_ = (n_) < 8;                                                                              \
    const int len_ = isctx_ ? CTXL : SEQL, sb_ = (isctx_ ? (n_) : (n_) - 8) * 32;                              \
    const int rowb_ = isctx_ ? NLAT + b * CTXL : b * SEQL;                                                     \
    const int plo_ = dir ? (len_ - 32 - sb_) : sb_;                                                            \
    _Pragma("unroll") for (int i = 0; i < 4; ++i) {                                                            \
      const int id_ = tid + 256 * i;                                                                           \
      if (id_ < 864) {                                                                                         \
        const int r_ = id_ / 24, cc_ = id_ - r_ * 24;                                                          \
        int pos_ = plo_ - 2 + r_;                                                                              \
        pos_ = pos_ < 0 ? 0 : (pos_ > len_ - 1 ? len_ - 1 : pos_);                                             \
        __builtin_amdgcn_global_load_lds(                                                                      \
            (const unsigned*)(P + (size_t)(rowb_ + pos_) * PC + C_DNQKV + (cc_ >> 3) * 256 + hd * 64 + (cc_ & 7) * 8), \
            (unsigned*)((char*)rawb + id_ * 16), 16, 0, 0);                                                    \
      }                                                                                                        \
    }                                                                                                          \
    if (tid >= 224) {                                                                                          \
      const int t_ = tid - 224, pos_ = dir ? (plo_ + 31 - t_) : (plo_ + t_);                                   \
      const bf16_t* pr_ = P + (size_t)(rowb_ + pos_) * PC;                                                     \
      ra = bf2f(pr_[C_DNA + dir * 4 + hd]);                                                                    \
      rb = bf2f(pr_[C_DNB + dir * 4 + hd]);                                                                    \
    }                                                                                                          \
  }

  DN_PREFETCH(0);
  asm volatile("s_waitcnt vmcnt(0)" ::: "memory");
  __syncthreads();
#pragma unroll 1
  for (int n = 0; n < 72; ++n) {
    const bool isctx = n < 8;
    const int len = isctx ? CTXL : SEQL;
    const int sbase = (isctx ? n : n - 8) * 32;
    const int rowbase = isctx ? NLAT + b * CTXL : b * SEQL;
    const int plo = dir ? (len - 32 - sbase) : sbase;
    if (tid < 192) {
      const int c4 = tid % 48, tg = tid / 48, part = c4 >> 4, cc = (c4 & 15) * 4;
      float4 w[5];
#pragma unroll
      for (int j = 0; j < 5; ++j) w[j] = *(const float4*)(wl + j * 192 + c4 * 4);
      float x0[12], x1[12], x2[12], x3[12];
#pragma unroll
      for (int r = 0; r < 12; ++r) {
        const int pp = plo + tg * 8 + r - 2;
        u32x2 rr = *(const u32x2*)(rawb + (tg * 8 + r) * 192 + c4 * 4);
        const bool ok = (pp >= 0) && (pp < len);
        rr.x = ok ? rr.x : 0u; rr.y = ok ? rr.y : 0u;
        x0[r] = bflo(rr.x); x1[r] = bfhi(rr.x); x2[r] = bflo(rr.y); x3[r] = bfhi(rr.y);
      }
      float* dbase = (part == 0) ? (qs + cc) : (part == 1) ? (ks + cc) : (vs + cc);
      const int dstride = (part == 2) ? 64 : 68;
#pragma unroll
      for (int uu = 0; uu < 8; ++uu) {
        float a0 = 0.f, a1 = 0.f, a2 = 0.f, a3 = 0.f;
#pragma unroll
        for (int j = 0; j < 5; ++j) {
          a0 += w[j].x * x0[uu + j]; a1 += w[j].y * x1[uu + j]; a2 += w[j].z * x2[uu + j]; a3 += w[j].w * x3[uu + j];
        }
        const int u = tg * 8 + uu, t = dir ? 31 - u : u;
        float4 o4; o4.x = silu(a0); o4.y = silu(a1); o4.z = silu(a2); o4.w = silu(a3);
        *(float4*)(dbase + t * dstride) = o4;
      }
    }
    if (tid >= 224) {
      const int t = tid - 224;
      const float xx = ra + dtb;
      const float sp = xx > 20.f ? xx : log1pf(__expf(xx));
      al[t] = __expf(-Aexp * sp);
      al[32 + t] = sigm(rb);
    }
    __syncthreads();
    {
      const int r = tid >> 2, pt = tid & 3;
      float* qp = (r < 32 ? qs + r * 68 : ks + (r - 32) * 68) + pt * 16;
      float s = 0.f;
#pragma unroll
      for (int i = 0; i < 16; ++i) s += qp[i] * qp[i];
      s = quad_sum(s);
      const float scq = rsqrtf(s + 1e-6f) * (r < 32 ? 0.125f : 1.f);
#pragma unroll
      for (int i = 0; i < 16; ++i) qp[i] *= scq;
    }
    __syncthreads();
    if (n + 1 < 72) DN_PREFETCH(n + 1);

    {
      const int did = tid >> 2, pp = did >> 2, wh = did & 3, part = tid & 3;
      const float* xr = (wh == 0) ? (ks + (2 * pp + 1) * 68) : (wh == 1) ? (qs + (2 * pp) * 68) : (qs + (2 * pp + 1) * 68);
      const float* yr = (wh == 3) ? (ks + (2 * pp + 1) * 68) : (ks + (2 * pp) * 68);
      float sdot = 0.f;
#pragma unroll
      for (int i = 0; i < 16; ++i) sdot += xr[part * 16 + i] * yr[part * 16 + i];
      sdot = quad_sum(sdot);
      if (part == 0) dots[did] = sdot;
    }
    __syncthreads();
#define DN_LD2(p_, K0_, K1_, Q0_, Q1_, AB_, VV_, DT_)                                \
  {                                                                                 \
    const int t_ = 2 * (p_);                                                        \
    _Pragma("unroll") for (int i = 0; i < 2; ++i) {                                 \
      K0_[i] = *(const float4*)(ks + t_ * 68 + kq * 8 + i * 4);                     \
      K1_[i] = *(const float4*)(ks + (t_ + 1) * 68 + kq * 8 + i * 4);               \
      Q0_[i] = *(const float4*)(qs + t_ * 68 + kq * 8 + i * 4);                     \
      Q1_[i] = *(const float4*)(qs + (t_ + 1) * 68 + kq * 8 + i * 4);               \
    }                                                                               \
    AB_.x = al[t_]; AB_.y = al[t_ + 1]; AB_.z = al[32 + t_]; AB_.w = al[33 + t_];   \
    VV_.x = vs[t_ * 64 + v]; VV_.y = vs[(t_ + 1) * 64 + v];                         \
    DT_ = *(const float4*)(dots + 4 * (p_));                                        \
  }
#define DN_PAIR(p_, K0_, K1_, Q0_, Q1_, AB_, VV_, DT_)                               \
  {                                                                                 \
    f32x2 k0[4], k1[4], q0[4], q1[4];                                               \
    _Pragma("unroll") for (int i = 0; i < 2; ++i) {                                 \
      k0[2 * i] = mk2(K0_[i].x, K0_[i].y); k0[2 * i + 1] = mk2(K0_[i].z, K0_[i].w); \
      k1[2 * i] = mk2(K1_[i].x, K1_[i].y); k1[2 * i + 1] = mk2(K1_[i].z, K1_[i].w); \
      q0[2 * i] = mk2(Q0_[i].x, Q0_[i].y); q0[2 * i + 1] = mk2(Q0_[i].z, Q0_[i].w); \
      q1[2 * i] = mk2(Q1_[i].x, Q1_[i].y); q1[2 * i + 1] = mk2(Q1_[i].z, Q1_[i].w); \
    }                                                                               \
    f32x2 ra = k0[0] * S2[0], rb2 = k1[0] * S2[0], re0 = q0[0] * S2[0], re1 = q1[0] * S2[0]; \
    _Pragma("unroll") for (int i = 1; i < 4; ++i) {                                 \
      ra += k0[i] * S2[i]; rb2 += k1[i] * S2[i]; re0 += q0[i] * S2[i]; re1 += q1[i] * S2[i]; \
    }                                                                               \
    float a_ = ra.x + ra.y, b_ = rb2.x + rb2.y, e0_ = re0.x + re0.y, e1_ = re1.x + re1.y; \
    OCT_SUM(a_); OCT_SUM(b_); OCT_SUM(e0_); OCT_SUM(e1_);                           \
    const float al0 = AB_.x, al1 = AB_.y, be0 = AB_.z, be1 = AB_.w;                 \
    const float d0 = be0 * (VV_.x - al0 * a_);                                      \
    const float kS1 = al0 * b_ + DT_.x * d0;                                        \
    const float d1 = be1 * (VV_.y - al1 * kS1);                                     \
    const float o0 = al0 * e0_ + DT_.y * d0;                                        \
    const float a01 = al0 * al1, c0 = al1 * d0;                                     \
    const float o1 = a01 * e1_ + al1 * DT_.z * d0 + DT_.w * d1;                     \
    const f32x2 a012 = mk2(a01, a01), c02 = mk2(c0, c0), d12 = mk2(d1, d1);         \
    _Pragma("unroll") for (int i = 0; i < 4; ++i) S2[i] = a012 * S2[i] + (c02 * k0[i] + d12 * k1[i]); \
    if (kq == 0) { vs[(2 * (p_)) * 64 + v] = o0; vs[(2 * (p_) + 1) * 64 + v] = o1; } \
  }
    {
      float4 k0A[2], k1A[2], q0A[2], q1A[2], abA, dtA; float2 vvA;
      float4 k0B[2], k1B[2], q0B[2], q1B[2], abB, dtB; float2 vvB;
      DN_LD2(0, k0A, k1A, q0A, q1A, abA, vvA, dtA);
#pragma unroll 1
      for (int pp = 0; pp < 16; pp += 2) {
        DN_LD2(pp + 1, k0B, k1B, q0B, q1B, abB, vvB, dtB);
        DN_PAIR(pp, k0A, k1A, q0A, q1A, abA, vvA, dtA);
        const int p2 = (pp + 2 < 16) ? pp + 2 : 15;
        DN_LD2(p2, k0A, k1A, q0A, q1A, abA, vvA, dtA);
        DN_PAIR(pp + 1, k0B, k1B, q0B, q1B, abB, vvB, dtB);
      }
    }
    asm volatile("s_waitcnt vmcnt(0)" ::: "memory");
    __syncthreads();
    {
      const int t = tid >> 3, pt = tid & 7;
      const int pos = dir ? (plo + 31 - t) : (plo + t);
      const float* op = vs + t * 64 + vh * 32 + pt * 4;
      u32x2 o0;
      o0.x = pack2(op[0], op[1]); o0.y = pack2(op[2], op[3]);
      *(u32x2*)(O + (size_t)(rowbase + pos) * 256 + hd * 64 + vh * 32 + pt * 4) = o0;
    }
    __syncthreads();
  }
}

__device__ __forceinline__ void hg_task(const Params& p, int l, int task, char* smem) {
  const int tid = otid(), lane = tid & 63, wid = tid >> 6;
  const int dir = task & 1, hd = (task >> 1) & 3, b = task >> 3;
  float* qs = (float*)smem;
  float* fs = qs + 64 * 68;
  float* vs = fs + 64 * 68;
  const bf16_t* P = WS_BF(p, OFF_P);
  bf16_t* O = WS_BF(p, OFF_SC) + (size_t)(2 + dir) * NTOK * 256;
  const int v = wid * 16 + (lane >> 2), kq = lane & 3;
  const int cc = (tid & 7) * 8, t0 = tid >> 3;
  float lb[8];
#pragma unroll
  for (int e = 0; e < 8; ++e) {
    const int c = hd * 64 + cc + e;
    lb[e] = (l == 0) ? 0.f : sigm(p.in[24][256 + c] - p.in[24][c]);
  }
  u32x4 rq[2], rf[2], rv[2];
  f32x2 S2[8];
#pragma unroll
  for (int i = 0; i < 8; ++i) S2[i] = mk2(0.f, 0.f);

#define HG_PREFETCH(n_)                                                                       \
  {                                                                                           \
    const bool isctx_ = (n_) < 4;                                                             \
    const int len_ = isctx_ ? CTXL : SEQL, sb_ = (isctx_ ? (n_) : (n_) - 4) * 64;             \
    const int rowb_ = isctx_ ? NLAT + b * CTXL : b * SEQL;                                    \
    const int plo_ = dir ? (len_ - 64 - sb_) : sb_;                                           \
    _Pragma("unroll") for (int i = 0; i < 2; ++i) {                                           \
      const int t_ = t0 + 32 * i, pos_ = dir ? (plo_ + 63 - t_) : (plo_ + t_);                \
      const bf16_t* pr_ = P + (size_t)(rowb_ + pos_) * PC;                                    \
      rq[i] = *(const u32x4*)(pr_ + C_HGQ + hd * 64 + cc);                                    \
      rf[i] = *(const u32x4*)(pr_ + C_HGF + dir * 256 + hd * 64 + cc);                        \
      rv[i] = *(const u32x4*)(pr_ + C_HGV + hd * 64 + cc);                                    \
    }                                                                                         \
  }

  HG_PREFETCH(0);
#pragma unroll 1
  for (int n = 0; n < 36; ++n) {
    const bool isctx = n < 4;
    const int len = isctx ? CTXL : SEQL;
    const int sbase = (isctx ? n : n - 4) * 64;
    const int rowbase = isctx ? NLAT + b * CTXL : b * SEQL;
    const int plo = dir ? (len - 64 - sbase) : sbase;
#pragma unroll
    for (int i = 0; i < 2; ++i) {
      const int t = t0 + 32 * i;
      float4 q4, f4, v4;
      q4.x = silu(bflo(rq[i].x)); q4.y = silu(bfhi(rq[i].x)); q4.z = silu(bflo(rq[i].y)); q4.w = silu(bfhi(rq[i].y));
      f4.x = fmaxf(lb[0] + (1.f - lb[0]) * sigm(bflo(rf[i].x)), 1e-30f);
      f4.y = fmaxf(lb[1] + (1.f - lb[1]) * sigm(bfhi(rf[i].x)), 1e-30f);
      f4.z = fmaxf(lb[2] + (1.f - lb[2]) * sigm(bflo(rf[i].y)), 1e-30f);
      f4.w = fmaxf(lb[3] + (1.f - lb[3]) * sigm(bfhi(rf[i].y)), 1e-30f);
      v4.x = bflo(rv[i].x); v4.y = bfhi(rv[i].x); v4.z = bflo(rv[i].y); v4.w = bfhi(rv[i].y);
      *(float4*)(qs + t * 68 + cc) = q4;
      *(float4*)(fs + t * 68 + cc) = f4;
      *(float4*)(vs + t * 64 + cc) = v4;
      q4.x = silu(bflo(rq[i].z)); q4.y = silu(bfhi(rq[i].z)); q4.z = silu(bflo(rq[i].w)); q4.w = silu(bfhi(rq[i].w));
      f4.x = fmaxf(lb[4] + (1.f - lb[4]) * sigm(bflo(rf[i].z)), 1e-30f);
      f4.y = fmaxf(lb[5] + (1.f - lb[5]) * sigm(bfhi(rf[i].z)), 1e-30f);
      f4.z = fmaxf(lb[6] + (1.f - lb[6]) * sigm(bflo(rf[i].w)), 1e-30f);
      f4.w = fmaxf(lb[7] + (1.f - lb[7]) * sigm(bfhi(rf[i].w)), 1e-30f);
      v4.x = bflo(rv[i].z); v4.y = bfhi(rv[i].z); v4.z = bflo(rv[i].w); v4.w = bfhi(rv[i].w);
      *(float4*)(qs + t * 68 + cc + 4) = q4;
      *(float4*)(fs + t * 68 + cc + 4) = f4;
      *(float4*)(vs + t * 64 + cc + 4) = v4;
    }
    __syncthreads();
    if (n + 1 < 36) HG_PREFETCH(n + 1);

#define HG_LD(t_, F_, Q_, V_)                                                       \
  {                                                                                 \
    _Pragma("unroll") for (int i = 0; i < 4; ++i) {                                 \
      F_[i] = *(const float4*)(fs + (t_) * 68 + kq * 16 + i * 4);                   \
      Q_[i] = *(const float4*)(qs + (t_) * 68 + kq * 16 + i * 4);                   \
    }                                                                               \
    V_ = vs[(t_) * 64 + v];                                                         \
  }
#define HG_STEP(t_, F_, Q_, V_)                                                     \
  {                                                                                 \
    f32x2 f2[8], q2[8];                                                             \
    _Pragma("unroll") for (int i = 0; i < 4; ++i) {                                 \
      f2[2 * i] = mk2(F_[i].x, F_[i].y); f2[2 * i + 1] = mk2(F_[i].z, F_[i].w);     \
      q2[2 * i] = mk2(Q_[i].x, Q_[i].y); q2[2 * i + 1] = mk2(Q_[i].z, Q_[i].w);     \
    }                                                                               \
    const f32x2 v2 = mk2(V_, V_);                                                   \
    _Pragma("unroll") for (int i = 0; i < 8; ++i) S2[i] = f2[i] * (S2[i] - v2) + v2; \
    f32x2 oa = q2[0] * S2[0], ob = q2[1] * S2[1];                                   \
    oa += q2[2] * S2[2]; ob += q2[3] * S2[3];                                       \
    oa += q2[4] * S2[4]; ob += q2[5] * S2[5];                                       \
    oa += q2[6] * S2[6]; ob += q2[7] * S2[7];                                       \
    const float o = quad_sum((oa.x + oa.y) + (ob.x + ob.y));                        \
    if (kq == 0) vs[(t_) * 64 + v] = o;                                             \
  }
    {
      float4 fA[4], qA[4], fB[4], qB[4];
      float vA, vB;
      HG_LD(0, fA, qA, vA);
#pragma unroll 1
      for (int t = 0; t < 64; t += 2) {
        HG_LD(t + 1, fB, qB, vB);
        HG_STEP(t, fA, qA, vA);
        const int t2 = (t + 2 < 64) ? t + 2 : 63;
        HG_LD(t2, fA, qA, vA);
        HG_STEP(t + 1, fB, qB, vB);
      }
    }
    __syncthreads();
    {
      const int t = tid >> 2, pt = tid & 3;
      const int pos = dir ? (plo + 63 - t) : (plo + t);
      const float* op = vs + t * 64 + pt * 16;
      u32x4 o0, o1;
      o0.x = pack2(op[0], op[1]); o0.y = pack2(op[2], op[3]); o0.z = pack2(op[4], op[5]); o0.w = pack2(op[6], op[7]);
      o1.x = pack2(op[8], op[9]); o1.y = pack2(op[10], op[11]); o1.z = pack2(op[12], op[13]); o1.w = pack2(op[14], op[15]);
      bf16_t* dst = O + (size_t)(rowbase + pos) * 256 + hd * 64 + pt * 16;
      *(u32x4*)dst = o0;
      *(u32x4*)(dst + 8) = o1;
    }
    __syncthreads();
  }
}

__device__ __forceinline__ void s5_task(const Params& p, int l, int task, char* smem) {
  const int tid = otid(), lane = tid & 63, wid = tid >> 6, fr = lane & 15, fq = lane >> 4;
  const int dir = task & 1, gq = (task >> 1) & 3, b = task >> 3, g = gq * 4 + wid;
  float* U = (float*)(smem + wid * 8704);
  bf16_t* Hs = (bf16_t*)(smem + wid * 8704 + 4096);
  const bf16_t* P = WS_BF(p, OFF_P);
  bf16_t* Y = WS_BF(p, OFF_SC) + (size_t)(4 + dir) * NTOK * 256;
  const int li = (l * 2 + dir) * 16 + g;
  const float lr = p.in[15][li * 64 + lane], lim = p.in[16][li * 64 + lane];
  const float st = expf(p.in[17][li]);
  const float mag = expf(lr * st);
  float sn, cs;
  sincosf(lim * st, &sn, &cs);
  const float are = mag * cs, aim = mag * sn;
  const float den = lr * lr + lim * lim, nre = are - 1.f;
  const float cre = (nre * lr + aim * lim) / den, cim = (aim * lr - nre * lim) / den;
  f32x2 bb[16];
  {
    const float* br = p.in[18] + ((size_t)(l * 16 + g) * 64 + lane) * 16;
    const float* bi = p.in[19] + ((size_t)(l * 16 + g) * 64 + lane) * 16;
#pragma unroll
    for (int h = 0; h < 16; ++h) {
      const float r_ = br[h], i_ = bi[h];
      bb[h] = mk2(cre * r_ - cim * i_, cre * i_ + cim * r_);
    }
  }
  bf16x8 cB[4];
  {
    const float* cr = p.in[20] + ((size_t)(l * 16 + g) * 16 + fr) * 64;
    const float* ci = p.in[21] + ((size_t)(l * 16 + g) * 16 + fr) * 64;
#pragma unroll
    for (int ks = 0; ks < 4; ++ks)
#pragma unroll
      for (int j = 0; j < 8; ++j) {
        const int K = 32 * ks + fq * 8 + j, pp = K >> 1;
        const float val = (K & 1) ? -ci[pp] : cr[pp];
        cB[ks][j] = (short)f2bf(val);
      }
  }
  f32x2 hh = mk2(0.f, 0.f);
  const f32x2 are2 = mk2(are, are), aim2 = mk2(-aim, aim);
  u32x4 r0, r1;
  {
    const u32x4* src = (const u32x4*)(P + (size_t)seq_row(b, dir, lane) * PC + C_S5U + g * 16);
    r0 = src[0]; r1 = src[1];
  }
#pragma unroll 1
  for (int n = 0; n < 36; ++n) {
    {
      float4* ud = (float4*)(U + lane * 16);
      ud[0] = float4{bflo(r0.x), bfhi(r0.x), bflo(r0.y), bfhi(r0.y)};
      ud[1] = float4{bflo(r0.z), bfhi(r0.z), bflo(r0.w), bfhi(r0.w)};
      ud[2] = float4{bflo(r1.x), bfhi(r1.x), bflo(r1.y), bfhi(r1.y)};
      ud[3] = float4{bflo(r1.z), bfhi(r1.z), bflo(r1.w), bfhi(r1.w)};
    }
    if (n + 1 < 36) {
      const u32x4* src = (const u32x4*)(P + (size_t)seq_row(b, dir, (n + 1) * 64 + lane) * PC + C_S5U + g * 16);
      r0 = src[0]; r1 = src[1];
    }
#define S5_LD(t_, U_)  { _Pragma("unroll") for (int i = 0; i < 4; ++i) U_[i] = *(const float4*)(U + (t_) * 16 + i * 4); }
#define S5_STEP(tt_, U_)                                                                      \
  {                                                                                           \
    f32x2 x0 = bb[0] * U_[0].x, x1 = bb[1] * U_[0].y, x2 = bb[2] * U_[0].z, x3 = bb[3] * U_[0].w; \
    x0 += bb[4] * U_[1].x; x1 += bb[5] * U_[1].y; x2 += bb[6] * U_[1].z; x3 += bb[7] * U_[1].w;  \
    x0 += bb[8] * U_[2].x; x1 += bb[9] * U_[2].y; x2 += bb[10] * U_[2].z; x3 += bb[11] * U_[2].w; \
    x0 += bb[12] * U_[3].x; x1 += bb[13] * U_[3].y; x2 += bb[14] * U_[3].z; x3 += bb[15] * U_[3].w; \
    const f32x2 xs = (x0 + x1) + (x2 + x3);                                                   \
    const f32x2 hsw = mk2(hh.y, hh.x);                                                        \
    hh = are2 * hh + (aim2 * hsw + xs);                                                       \
    *(unsigned*)(Hs + (tt_) * 136 + 2 * lane) = pack2(hh.x, hh.y);                            \
  }
#pragma unroll 1
    for (int sub = 0; sub < 4; ++sub) {
      float4 uA[4], uB[4];
      S5_LD(sub * 16, uA);
#pragma unroll
      for (int tt = 0; tt < 16; tt += 2) {
        S5_LD(sub * 16 + tt + 1, uB);
        S5_STEP(tt, uA);
        if (tt + 2 < 16) S5_LD(sub * 16 + tt + 2, uA);
        S5_STEP(tt + 1, uB);
      }
      f32x4 y = {0.f, 0.f, 0.f, 0.f};
#pragma unroll
      for (int ks = 0; ks < 4; ++ks) {
        const bf16x8 a = *(const bf16x8*)(Hs + fr * 136 + 32 * ks + fq * 8);
        y = __builtin_amdgcn_mfma_f32_16x16x32_bf16(cB[ks], a, y, 0, 0, 0);
      }
      {
        const int row = seq_row(b, dir, n * 64 + sub * 16 + fr);
        u32x2 pk; pk.x = pack2(y[0], y[1]); pk.y = pack2(y[2], y[3]);
        *(u32x2*)(Y + (size_t)row * 256 + g * 16 + fq * 4) = pk;
      }
    }
  }
}

__device__ __forceinline__ void attn_task(const Params& p, int l, int task, bool isctx, char* smem) {
  const int tid = otid(), lane = tid & 63, wid = tid >> 6, fr = lane & 15, fq = lane >> 4;
  int qt, kvh, b, nkt;
  if (!isctx) { qt = task & 31; kvh = (task >> 5) & 1; b = task >> 6; nkt = 36; }
  else { qt = task & 3; kvh = (task >> 2) & 1; b = task >> 3; nkt = 4; }
  bf16_t* P = WS_BF(p, OFF_P);
  const int rowq = (isctx ? NLAT + b * CTXL : b * SEQL) + qt * 64 + wid * 16 + fr;
  bf16x8 qB[2][2];
#pragma unroll
  for (int g = 0; g < 2; ++g)
#pragma unroll
    for (int ks = 0; ks < 2; ++ks) qB[g][ks] = *(const bf16x8*)(P + (size_t)rowq * PC + C_ATQ + (kvh * 2 + g) * 64 + ks * 32 + fq * 8);
  const bf16_t* Kg = WS_BF(p, OFF_KP) + (size_t)(b * 2 + kvh) * TJ * 64;
  const bf16_t* Vg = WS_BF(p, OFF_VT) + (size_t)(b * 2 + kvh) * 64 * TJ;
  const int o0 = tid * 16;
  const int lrow = (o0 >> 10) * 8 + ((o0 >> 7) & 7), lcol = ((((o0 >> 4) & 7) ^ ((lrow >> 1) & 7))) * 8;
  const int inner = frag_off(fr, fq);
  const bf16_t* kgl = Kg + (size_t)lrow * 64 + lcol;
  const bf16_t* vgl = Vg + (size_t)lrow * TJ + lcol;
#define AT_ISSUE(kt0_, base_)                                                                                                \
  {                                                                                                                          \
    _Pragma("unroll") for (int h_ = 0; h_ < 2; ++h_) {                                                                       \
      const int tl_ = (kt0_) + h_;                                                                                           \
      _Pragma("unroll") for (int i = 0; i < 2; ++i) {                                                                        \
        __builtin_amdgcn_global_load_lds((const unsigned*)(kgl + (size_t)(tl_ * 64 + 32 * i) * 64),                          \
                                         (unsigned*)(smem + (base_) + h_ * 16384 + i * 4096 + o0), 16, 0, 0);                \
        __builtin_amdgcn_global_load_lds((const unsigned*)(vgl + (size_t)(32 * i) * TJ + tl_ * 64),                          \
                                         (unsigned*)(smem + (base_) + h_ * 16384 + 8192 + i * 4096 + o0), 16, 0, 0);         \
      }                                                                                                                      \
    }                                                                                                                        \
  }
  AT_ISSUE(0, 0);
  asm volatile("s_waitcnt vmcnt(0)" ::: "memory");
  __builtin_amdgcn_s_barrier();
  float gqm = fabsf(p.in[26][l * 64 + lane]), gkm = fabsf(p.in[27][l * 64 + lane]);
#pragma unroll
  for (int o = 32; o >= 1; o >>= 1) { gqm = fmaxf(gqm, __shfl_xor(gqm, o)); gkm = fmaxf(gkm, __shfl_xor(gkm, o)); }
  const float Bsh = 1.02f * (0.125f * 1.4426950408889634f * 64.f) * gqm * gkm;
  float lsum[2] = {0.f, 0.f};
  f32x4 O[4][2];
  zero_acc<2>(O);
  for (int kt = 0; kt < nkt; kt += 2) {
    const int base = ((kt >> 1) & 1) * 32768;
    if (kt + 2 < nkt) AT_ISSUE(kt + 2, 32768 - base);
    __builtin_amdgcn_sched_barrier(0);
#pragma unroll 1
    for (int hh = 0; hh < 2; ++hh) {
    const int cur = base + hh * 16384;
    f32x4 s[4][2];
#pragma unroll
    for (int i = 0; i < 4; ++i)
#pragma unroll
      for (int g = 0; g < 2; ++g) s[i][g] = f32x4{-Bsh, -Bsh, -Bsh, -Bsh};
    __builtin_amdgcn_s_setprio(1);
#pragma unroll
    for (int i = 0; i < 4; ++i)
#pragma unroll
      for (int ks = 0; ks < 2; ++ks) {
        const bf16x8 kf = *(const bf16x8*)(smem + cur + ((i * 2048 + inner) ^ (ks * 64)));
#pragma unroll
        for (int g = 0; g < 2; ++g) s[i][g] = __builtin_amdgcn_mfma_f32_16x16x32_bf16(kf, qB[g][ks], s[i][g], 0, 0, 0);
      }
    __builtin_amdgcn_s_setprio(0);
    __builtin_amdgcn_sched_barrier(0);
    bf16x8 pB[2][2];
#pragma unroll
    for (int g = 0; g < 2; ++g) {
      float ps = 0.f;
#pragma unroll
      for (int i = 0; i < 4; ++i)
#pragma unroll
        for (int j = 0; j < 4; ++j) { const float pv = __builtin_amdgcn_exp2f(s[i][g][j]); s[i][g][j] = pv; ps += pv; }
      lsum[g] += ps;
#pragma unroll
      for (int ii = 0; ii < 2; ++ii) {
        union { u32x4 u; bf16x8 v; } cv;
        cv.u.x = pack2(s[2 * ii][g][0], s[2 * ii][g][1]);
        cv.u.y = pack2(s[2 * ii][g][2], s[2 * ii][g][3]);
        cv.u.z = pack2(s[2 * ii + 1][g][0], s[2 * ii + 1][g][1]);
        cv.u.w = pack2(s[2 * ii + 1][g][2], s[2 * ii + 1][g][3]);
        pB[g][ii] = cv.v;
      }
    }
    __builtin_amdgcn_sched_barrier(0);
    __builtin_amdgcn_s_setprio(1);
#pragma unroll
    for (int mt = 0; mt < 4; ++mt)
#pragma unroll
      for (int ii = 0; ii < 2; ++ii) {
        const bf16x8 vf = *(const bf16x8*)(smem + cur + 8192 + ((mt * 2048 + inner) ^ (ii * 64)));
#pragma unroll
        for (int g = 0; g < 2; ++g) O[mt][g] = __builtin_amdgcn_mfma_f32_16x16x32_bf16(vf, pB[g][ii], O[mt][g], 0, 0, 0);
      }
    __builtin_amdgcn_s_setprio(0);
    }
    __builtin_amdgcn_sched_barrier(0);
    asm volatile("s_waitcnt vmcnt(0)" ::: "memory");
    __builtin_amdgcn_s_barrier();
  }
#undef AT_ISSUE
#pragma unroll
  for (int g = 0; g < 2; ++g) {
    float ls = lsum[g];
    ls += __shfl_xor(ls, 16);
    ls += __shfl_xor(ls, 32);
    const float inv = 1.f / ls;
#pragma unroll
    for (int mt = 0; mt < 4; ++mt) {
      u32x2 o;
      o.x = pack2(O[mt][g][0] * inv, O[mt][g][1] * inv);
      o.y = pack2(O[mt][g][2] * inv, O[mt][g][3] * inv);
      *(u32x2*)(P + (size_t)rowq * PC + C_YAT + (kvh * 2 + g) * 64 + mt * 16 + fq * 4) = o;
    }
  }
}

__device__ __forceinline__ void phase_mixers(const Params& p, int l, char* smem, bool scans_only) {
  int* s_taskp = (int*)smem;
  int* ctr = (int*)(p.ws + OFF_CTR) + l + (scans_only ? 2 : 0);
  const int n_dn = 256, n_hg = 128, n_s5 = 128, n_al = 1024, n_ac = (l == 0) ? 128 : 0;
  const int n_scan = n_dn + n_hg + n_s5;
  const int total = scans_only ? n_scan : (n_scan + n_al + n_ac);
  const bool full = (gridDim.x >= 512);
  int first = -1;
  if (full) {
    const int bx = blockIdx.x;
    if (bx < 512) first = bx;
  }
  for (int it = 0;; ++it) {
    int t;
    if (it == 0 && first >= 0) t = first;
    else {
      if (otid() == 0) *s_taskp = atomicAdd(ctr, 1) + (full ? n_scan : 0);
      __syncthreads();
      t = *s_taskp;
      __syncthreads();
    }
    if (t >= total) break;
    if (t < n_dn) dn_task(p, l, t, smem);
    else if (t < n_dn + n_hg) hg_task(p, l, t - n_dn, smem);
    else if (t < n_scan) s5_task(p, l, t - n_dn - n_hg, smem);
    else { const bool ic = t >= n_scan + n_al; attn_task(p, l, t - n_scan - (ic ? n_al : 0), ic, smem); }
    __syncthreads();
  }
}

__device__ __forceinline__ float sum16(float v) {
  v += __shfl_xor(v, 1); v += __shfl_xor(v, 2); v += __shfl_xor(v, 4); v += __shfl_xor(v, 8);
  return v;
}
__device__ __forceinline__ void phase_postmix(const Params& p, int l, int nrows) {
  bf16_t* P = WS_BF(p, OFF_P);
  const bf16_t* SC = WS_BF(p, OFF_SC);
  const int tidq = otid(); const int lane = tidq & 63, c0 = lane * 4, hc = c0 & 63;
  const float4 gdn = *(const float4*)(p.in[14] + l * 64 + hc);
  const float4 ghg = *(const float4*)(p.in[25] + l * 64 + hc);
  const float4 dsk = *(const float4*)(p.in[22] + l * 256 + c0);
  for (int r = blockIdx.x * 4 + (tidq >> 6); r < nrows; r += gridDim.x * 4) {
    bf16_t* pr = P + (size_t)r * PC;
    const size_t so = (size_t)r * 256 + c0;
    const size_t st = (size_t)NTOK * 256;
    {
      const u32x2 a = *(const u32x2*)(SC + so), bq = *(const u32x2*)(SC + st + so);
      const float o0 = bflo(a.x) + bflo(bq.x), o1 = bfhi(a.x) + bfhi(bq.x), o2 = bflo(a.y) + bflo(bq.y), o3 = bfhi(a.y) + bfhi(bq.y);
      const float ss = sum16(o0 * o0 + o1 * o1 + o2 * o2 + o3 * o3);
      const float rstd = rsqrtf(ss * (1.f / 64.f) + 1e-6f);
      const u32x2 z = *(const u32x2*)(pr + C_DNZ + c0);
      u32x2 o;
      o.x = pack2(o0 * rstd * gdn.x * silu(bflo(z.x)), o1 * rstd * gdn.y * silu(bfhi(z.x)));
      o.y = pack2(o2 * rstd * gdn.z * silu(bflo(z.y)), o3 * rstd * gdn.w * silu(bfhi(z.y)));
      *(u32x2*)(pr + C_YDN + c0) = o;
    }
    {
      const u32x2 a = *(const u32x2*)(SC + 2 * st + so), bq = *(const u32x2*)(SC + 3 * st + so);
      const float o0 = bflo(a.x) + bflo(bq.x), o1 = bfhi(a.x) + bfhi(bq.x), o2 = bflo(a.y) + bflo(bq.y), o3 = bfhi(a.y) + bfhi(bq.y);
      const float ss = sum16(o0 * o0 + o1 * o1 + o2 * o2 + o3 * o3);
      const float rstd = rsqrtf(ss * (1.f / 64.f) + 1e-6f);
      const u32x2 z = *(const u32x2*)(pr + C_HGG + c0);
      u32x2 o;
      o.x = pack2(o0 * rstd * ghg.x * sigm(bflo(z.x)), o1 * rstd * ghg.y * sigm(bfhi(z.x)));
      o.y = pack2(o2 * rstd * ghg.z * sigm(bflo(z.y)), o3 * rstd * ghg.w * sigm(bfhi(z.y)));
      *(u32x2*)(pr + C_YHG + c0) = o;
    }
    {
      const u32x2 a = *(const u32x2*)(SC + 4 * st + so), bq = *(const u32x2*)(SC + 5 * st + so);
      const u32x2 u = *(const u32x2*)(pr + C_S5U + c0);
      float y[4];
      y[0] = bflo(a.x) + bflo(bq.x) + dsk.x * bflo(u.x);
      y[1] = bfhi(a.x) + bfhi(bq.x) + dsk.y * bfhi(u.x);
      y[2] = bflo(a.y) + bflo(bq.y) + dsk.z * bflo(u.y);
      y[3] = bfhi(a.y) + bfhi(bq.y) + dsk.w * bfhi(u.y);
#pragma unroll
      for (int e = 0; e < 4; ++e) {
        const float x = y[e];
        const float uu = 0.7978845608028654f * (x + 0.044715f * x * x * x);
        const float th = 1.f - 2.f / (1.f + __expf(2.f * uu));
        y[e] = 0.5f * x * (1.f + th);
      }
      u32x2 o; o.x = pack2(y[0], y[1]); o.y = pack2(y[2], y[3]);
      *(u32x2*)(pr + C_S5G + c0) = o;
    }
  }
}


#define XB_XCNT(j) (256 + 64 * (j))
#define XB_XSUB(j) (1280 + 64 * (j))
#define XB_XGEN(j) (2304 + 64 * (j))
#define XB_TOP 3328
#define XB_TOPGEN 3392
#define TICKET_BASE 3600
__device__ __forceinline__ unsigned xb_ld(unsigned* q) { return __hip_atomic_load(q, __ATOMIC_RELAXED, __HIP_MEMORY_SCOPE_AGENT); }
__device__ __forceinline__ unsigned xb_add(unsigned* q, unsigned v) { return __hip_atomic_fetch_add(q, v, __ATOMIC_RELAXED, __HIP_MEMORY_SCOPE_AGENT); }
__device__ __forceinline__ void grid_bar(unsigned* bar, unsigned k, unsigned x, unsigned nloc, unsigned nx) {
  asm volatile("s_waitcnt vmcnt(0)" ::: "memory");
  __syncthreads();
  if (threadIdx.x == 0) {
    __builtin_amdgcn_s_waitcnt(0);
    const unsigned old = xb_add(&bar[XB_XSUB(x)], 1u);
    if (old + 1u == k * nloc) {
      __builtin_amdgcn_fence(__ATOMIC_RELEASE, "agent");
      asm volatile("s_waitcnt vmcnt(0)" ::: "memory");
      const unsigned og = xb_add(&bar[XB_TOP], 1u);
      if (og + 1u == k * nx) xb_add(&bar[XB_TOPGEN], 1u);
      else while (xb_ld(&bar[XB_TOPGEN]) < k) __builtin_amdgcn_s_sleep(1);
      __builtin_amdgcn_fence(__ATOMIC_ACQUIRE, "agent");
      xb_add(&bar[XB_XGEN(x)], 1u);
      asm volatile("s_waitcnt vmcnt(0)" ::: "memory");
    } else {
      while (xb_ld(&bar[XB_XGEN(x)]) < k) __builtin_amdgcn_s_sleep(1);
      __builtin_amdgcn_fence(__ATOMIC_ACQUIRE, "agent");
      asm volatile("s_waitcnt vmcnt(0)" ::: "memory");
    }
  }
  __syncthreads();
}
__global__ void __launch_bounds__(256, 2) fwd_megakernel(Params p) {
  __shared__ __attribute__((aligned(16))) char smem[65536];
  cg::grid_group grid = cg::this_grid();
  unsigned* barc = (unsigned*)(p.ws + OFF_CTR);
  const unsigned xcc = (unsigned)__builtin_amdgcn_s_getreg((3 << 11) | 20) & 0xFu;
  if (threadIdx.x == 0) (void)xb_add(&barc[XB_XCNT(xcc)], 1u);
  unsigned bar_n = 0, nloc = 1, nx = 1;
  for (int rpt = 0; rpt < ((PROBE_MASK & 8) ? 2 : 1); ++rpt) phase_ada(p, smem);
#pragma unroll 1
  for (int step = 0; step < 28; ++step) {
    const int l = step / 14, k = step - l * 14;
    const bf16_t* Wb = WS_BF(p, OFF_W);
    const int mr2 = (l == 1) ? NLAT : NTOK;
    if (k == 0) {
      for (int rpt = 0; rpt < ((PROBE_MASK & 8) ? 2 : 1); ++rpt) phase_cvt(p, l, smem);
      if (l == 0) {
        grid.sync();
        unsigned cnt = 0;
        for (unsigned j = 0; j < 16; ++j) { const unsigned c = xb_ld(&barc[XB_XCNT(j)]); cnt += (c > 0u) ? 1u : 0u; if (j == xcc) nloc = c; }
        nx = cnt;
      }
    }
    if (k == 0 || k == 3 || k == 11) {
      const int which = (k == 0) ? 0 : (k == 3) ? 1 : 2;
      for (int rpt = 0; rpt < ((PROBE_MASK & 4) ? 2 : 1); ++rpt) phase_norm(p, l, which, k == 11 ? mr2 : NTOK);
    } else if (k == 1 || k == 12) {
      phase_ffn_up(p, k == 1 ? 0 : 1, k == 1 ? NTOK : mr2, smem, barc + TICKET_BASE + step * 8);
    } else if (k == 2 || k == 10 || k == 13) {
      const bf16_t* A = (k == 10) ? WS_BF(p, OFF_SC) : WS_BF(p, OFF_P);
      const int lda = (k == 10) ? DM : DFF;
      const bf16_t* Wt = (k == 10) ? Wb + W_OT : (k == 2) ? Wb + W_DN : Wb + W_DN + (size_t)1024 * 2816;
      const int gate_k = (k == 2) ? 2 : (k == 10) ? 5 : 8;
      const float scale = (k == 10) ? 1.0f : 0.5f;
      phase_resid_gemm(p, A, lda, Wt, lda, l, gate_k, scale, (l == 0 && k == 2), k == 2 ? NTOK : mr2, smem, barc + TICKET_BASE + step * 8);
    } else if (k == 4) {
      phase_win(p, smem, barc + TICKET_BASE + step * 8);
    } else if (k == 5) {
      phase_attn_prep(p, l);
    } else if (k == 6) {
      phase_mixers(p, l, smem, false);
      if (PROBE_MASK & 2) { grid_bar(barc, ++bar_n, xcc, nloc, nx); phase_mixers(p, l, smem, true); }
    } else if (k == 7) {
      for (int rpt = 0; rpt < ((PROBE_MASK & 4) ? 2 : 1); ++rpt) phase_postmix(p, l, mr2);
    } else if (k == 8) {
      for (int rpt = 0; rpt < ((PROBE_MASK & 1) ? 2 : 1); ++rpt) phase_glu(p, mr2, smem);
    } else if (k == 9) {
      for (int rpt = 0; rpt < ((PROBE_MASK & 1) ? 2 : 1); ++rpt) phase_merge(p, mr2, smem);
    }
    grid_bar(barc, ++bar_n, xcc, nloc, nx);
    if (PROBE_MASK & 16) grid_bar(barc, ++bar_n, xcc, nloc, nx);
  }
  phase_final_norm(p);
}

static void build_jobs(Params& p, int l) {
  bf16_t* W = (bf16_t*)(p.ws + OFF_W);
  CvtJob* J = p.jobs + l * 15;
  int n = 0, tiles = 0;
  auto add = [&](const float* src, bf16_t* dst, int K, int N, int nsrc, int ld_src, int ld_dst, int mode) {
    CvtJob j;
    memset(&j, 0, sizeof(j));
    j.src = src; j.dst = dst; j.K = K; j.N = N; j.nsrc = nsrc; j.ld_src = ld_src; j.ld_dst = ld_dst; j.mode = mode;
    j.ntk = K / 64; j.tile0 = tiles;
    tiles += (K / 64) * ((N + 63) / 64);
    J[n++] = j;
  };
  const float* w1 = p.in[7]; const float* w3 = p.in[8]; const float* w2 = p.in[9];
  for (int half = 0; half < 2; ++half) {
    add(w1 + (size_t)(l * 2 + half) * 1024 * 2816, W + W_UP + (size_t)half * 5632 * 1024, 1024, 2816, 2816, 2816, 1024, 1);
    add(w3 + (size_t)(l * 2 + half) * 1024 * 2816, W + W_UP + (size_t)half * 5632 * 1024, 1024, 2816, 2816, 2816, 1024, 2);
    add(w2 + (size_t)(l * 2 + half) * 2816 * 1024, W + W_DN + (size_t)half * 1024 * 2816, 2816, 1024, 1024, 1024, 2816, 0);
  }
  const float* win = p.in[10] + (size_t)l * 1024 * 7184;
  add(win, W + W_IN, 1024, 3200, 3088, 7184, 1024, 0);
  add(win + 3088, W + W_GT, 1024, 4096, 4096, 7184, 1024, 0);
  for (int i = 0; i < 4; ++i) add(p.in[28] + (size_t)(l * 4 + i) * 256 * 1024, W + W_BT + (size_t)i * 1024 * 256, 256, 1024, 1024, 1024, 256, 0);
  add(p.in[29] + (size_t)l * 1024 * 1024, W + W_OT, 1024, 1024, 1024, 1024, 1024, 0);
  add(p.in[23] + (size_t)l * 256 * 512, W + W_GLU, 256, 256, 256, 512, 256, 1);
  add(p.in[23] + (size_t)l * 256 * 512 + 256, W + W_GLU, 256, 256, 256, 512, 256, 2);
  p.job_tiles[l] = tiles;
}

extern "C" void kernel_launch(void* const* d_in, const int* in_sizes, int n_in, void* d_out, int out_size, void* d_ws, size_t ws_size,
                              hipStream_t stream) {
  static int grid_blocks = 0;
  if (!grid_blocks) {
    if (n_in != 31 || ws_size < WS_END) { fprintf(stderr, "kernel_launch: unexpected n_in %d / ws_size %zu (need %zu)\n", n_in, ws_size, (size_t)WS_END); grid_blocks = -1; return; }
    int dev = 0, cus = 0, per_cu = 0;
    hipGetDevice(&dev);
    hipDeviceGetAttribute(&cus, hipDeviceAttributeMultiprocessorCount, dev);
    hipOccupancyMaxActiveBlocksPerMultiprocessor(&per_cu, fwd_megakernel, 256, 0);
    if (per_cu < 1) per_cu = 1;
    if (per_cu > 2) per_cu = 2;
    grid_blocks = cus * per_cu;
    fprintf(stderr, "kernel_launch: grid %d (%d CUs x %d)\n", grid_blocks, cus, per_cu);
  }
  if (grid_blocks < 0) return;
  Params p;
  memset(&p, 0, sizeof(p));
  for (int i = 0; i < 31; ++i) p.in[i] = (const float*)d_in[i];
  p.out = (float*)d_out;
  p.ws = (char*)d_ws;
  build_jobs(p, 0);
  build_jobs(p, 1);
  if (hipMemsetAsync((char*)d_ws + OFF_CTR, 0, CTL_BYTES, stream) != hipSuccess) { fprintf(stderr, "kernel_launch: memset failed\n"); return; }
  void* args[] = {&p};
  hipError_t e = hipLaunchCooperativeKernel((void*)fwd_megakernel, dim3(grid_blocks), dim3(256), args, 0, stream);
  if (e != hipSuccess) fprintf(stderr, "cooperative launch failed: %s (grid %d)\n", hipGetErrorString(e), grid_blocks);
}
```
